# Optimizing an MI355X kernel written in HIP

```python
import math
import jax, jax.numpy as jnp
from jax import lax
import numpy as np

D_MODEL = 1024
BATCH = 4
SEQ = 4096
DEPTH = 4

N_MIXERS = 3
N_RET = (DEPTH + 2) // 3
N_MOBA = (DEPTH + 1) // 3
N_DIFF = DEPTH // 3

RET_HEADS = 4
RET_DK = D_MODEL // RET_HEADS
RET_DV = 2 * RET_DK
RET_CHUNK = 128
ROPE_BASE = 10000.0

ATTN_HEADS = 16
HEAD_DIM = D_MODEL // ATTN_HEADS
MOBA_BLOCK = 256
MOBA_TOPK = 3
MOBA_Q_CHUNK = 16
DIFF_HEADS = ATTN_HEADS // 2
DIFF_V_DIM = 2 * HEAD_DIM
ATTN_Q_BLOCK = 128

REL_BUCKETS = 32
REL_MAX_EXACT = REL_BUCKETS // 2
REL_MAX_DISTANCE = 1024

D_FF = 4 * D_MODEL
EPS = 1e-6
NEG = -1e30

kernel_name = "hybrid_retention_moba_diffattn_trunk"


def _rmsnorm(x, w):
    xf = x.astype(jnp.float32)
    y = xf * lax.rsqrt(jnp.mean(xf * xf, axis=-1, keepdims=True) + EPS)
    return y.astype(x.dtype) * w


def _rel_bucket(dist):
    n = jnp.maximum(dist, 0)
    nf = jnp.maximum(n, 1).astype(jnp.float32)
    large = REL_MAX_EXACT + (jnp.log(nf / REL_MAX_EXACT) / math.log(REL_MAX_DISTANCE / REL_MAX_EXACT)
                             * (REL_BUCKETS - REL_MAX_EXACT)).astype(jnp.int32)
    large = jnp.minimum(large, REL_BUCKETS - 1)
    return jnp.where(n < REL_MAX_EXACT, n, large)


def _rotary(x):
    S, d = x.shape[2], x.shape[3]
    inv_freq = ROPE_BASE ** (-jnp.arange(0, d, 2, dtype=jnp.float32) / d)
    ang = jnp.arange(S, dtype=jnp.float32)[:, None] * inv_freq[None, :]
    cos, sin = jnp.cos(ang), jnp.sin(ang)
    x1, x2 = x[..., : d // 2], x[..., d // 2:]
    return jnp.concatenate([x1 * cos - x2 * sin, x1 * sin + x2 * cos], axis=-1)


def _squared_relu_mlp(h, w_up, w_down):
    u = jax.nn.relu(h @ w_up)
    return (u * u) @ w_down


def _retention_mixer(h, w_in, w_out):
    B, S, _ = h.shape
    H, dk, dv, C = RET_HEADS, RET_DK, RET_DV, RET_CHUNK
    N = S // C
    proj = (h @ w_in).astype(jnp.float32)
    q, k, v, g = jnp.split(proj, [H * dk, 2 * H * dk, 2 * H * dk + H * dv], axis=-1)
    q = _rotary(q.reshape(B, S, H, dk).transpose(0, 2, 1, 3))
    k = _rotary(k.reshape(B, S, H, dk).transpose(0, 2, 1, 3)) * (dk ** -0.5)
    v = v.reshape(B, S, H, dv).transpose(0, 2, 1, 3)

    log_gamma = jnp.log(1.0 - 2.0 ** (-5.0 - jnp.arange(H, dtype=jnp.float32)))
    pos = jnp.arange(C, dtype=jnp.float32)
    rel = pos[:, None] - pos[None, :]
    inner_decay = jnp.where(rel >= 0, jnp.exp(jnp.maximum(rel, 0.0)[None] * log_gamma[:, None, None]), 0.0)

    qc = q.reshape(B, H, N, C, dk)
    kc = k.reshape(B, H, N, C, dk)
    vc = v.reshape(B, H, N, C, dv)
    s_in = jnp.einsum('bhnid,bhnjd->bhnij', qc, kc) * inner_decay[:, None]
    inner = jnp.einsum('bhnij,bhnjv->bhniv', s_in, vc)
    q_dec = qc * jnp.exp((pos + 1.0)[None, :] * log_gamma[:, None])[:, None, :, None]
    k_dec = kc * jnp.exp((C - 1.0 - pos)[None, :] * log_gamma[:, None])[:, None, :, None]
    chunk_decay = jnp.exp(C * log_gamma)[:, None, None]

    def step(state, xs):
        qn, kn, vn = xs
        out = jnp.einsum('bhid,bhdv->bhiv', qn, state)
        state = state * chunk_decay + jnp.einsum('bhjd,bhjv->bhdv', kn, vn)
        return state, out

    xs = (jnp.moveaxis(q_dec, 2, 0), jnp.moveaxis(k_dec, 2, 0), jnp.moveaxis(vc, 2, 0))
    _, cross = lax.scan(step, jnp.zeros((B, H, dk, dv), jnp.float32), xs)
    o = (inner + jnp.moveaxis(cross, 0, 2)).reshape(B, H, S, dv)
    o = o * lax.rsqrt(jnp.mean(o * o, axis=-1, keepdims=True) + EPS)
    o = o.transpose(0, 2, 1, 3).reshape(B, S, H * dv)
    return ((jax.nn.silu(g) * o) @ w_out).astype(h.dtype)


def _moba_mixer(h, w_in, q_norm_w, k_norm_w, w_out, rel_bias):
    B, S, _ = h.shape
    H, d, BS, QC = ATTN_HEADS, HEAD_DIM, MOBA_BLOCK, MOBA_Q_CHUNK
    proj = h @ w_in
    q, k, v = jnp.split(proj, 3, axis=-1)
    q = _rmsnorm(q.reshape(B, S, H, d), q_norm_w).transpose(0, 2, 1, 3).astype(jnp.float32) * (d ** -0.5)
    k = _rmsnorm(k.reshape(B, S, H, d), k_norm_w).transpose(0, 2, 1, 3).astype(jnp.float32)
    v = v.reshape(B, S, H, d).transpose(0, 2, 1, 3)
    NB = -(-S // BS)
    pad = NB * BS - S
    k_pad = jnp.pad(k, ((0, 0), (0, 0), (0, pad), (0, 0)))
    v_pad = jnp.pad(v, ((0, 0), (0, 0), (0, pad), (0, 0)))
    kb = k_pad.reshape(B, H, NB, BS, d)
    vb = v_pad.reshape(B, H, NB, BS, d)
    k_mean = kb.mean(axis=3)
    topk = min(MOBA_TOPK, NB)
    bias_t = rel_bias.T.astype(jnp.float32)
    head_idx = jnp.arange(H)[None, :, None, None, None]
    in_block = jnp.arange(BS)
    gather = jax.vmap(jax.vmap(lambda blocks, ix: blocks[ix]))

    def chunk(c):
        t0 = c * QC
        b = t0 // BS
        t = t0 + jnp.arange(QC)
        qc = lax.dynamic_slice_in_dim(q, t0, QC, axis=2)
        gate = jnp.einsum('bhqd,bhnd->bhqn', qc, k_mean)
        gate = jnp.where(jnp.arange(NB) < b, gate, NEG)
        _, idx = lax.top_k(gate, topk)
        valid = idx < b
        k_sel = gather(kb, idx)
        v_sel = gather(vb, idx)
        s_sel = jnp.einsum('bhqd,bhqkjd->bhqkj', qc, k_sel)
        kpos = idx[..., None] * BS + in_block
        s_sel = s_sel + bias_t[head_idx, _rel_bucket(t[:, None, None] - kpos)]
        s_sel = jnp.where(valid[..., None], s_sel, NEG)
        k_own = lax.dynamic_slice_in_dim(k_pad, b * BS, BS, axis=2)
        v_own = lax.dynamic_slice_in_dim(v_pad, b * BS, BS, axis=2)
        dist = t[:, None] - (b * BS + in_block)[None, :]
        s_own = jnp.einsum('bhqd,bhjd->bhqj', qc, k_own) + bias_t[:, _rel_bucket(dist)]
        s_own = jnp.where(dist >= 0, s_own, NEG)
        scores = jnp.concatenate([s_sel.reshape(B, H, QC, topk * BS), s_own], axis=-1)
        p = jax.nn.softmax(scores, axis=-1)
        p_sel = p[..., : topk * BS].reshape(B, H, QC, topk, BS)
        p_own = p[..., topk * BS:]
        return (jnp.einsum('bhqkj,bhqkjd->bhqd', p_sel, v_sel)
                + jnp.einsum('bhqj,bhjd->bhqd', p_own, v_own))

    outs = lax.map(chunk, jnp.arange(S // QC))
    o = outs.transpose(1, 2, 0, 3, 4).reshape(B, H, S, d).transpose(0, 2, 1, 3).reshape(B, S, H * d)
    return (o @ w_out).astype(h.dtype)


def _diff_mixer(h, w_in, q_norm_w, k_norm_w, lambdas, subln_w, w_out, rel_bias, lambda_init):
    B, S, _ = h.shape
    H2, d, QB = 2 * DIFF_HEADS, HEAD_DIM, ATTN_Q_BLOCK
    proj = h @ w_in
    q, k, v = jnp.split(proj, 3, axis=-1)
    q = _rmsnorm(q.reshape(B, S, H2, d), q_norm_w).transpose(0, 2, 1, 3).astype(jnp.float32) * (d ** -0.5)
    k = _rmsnorm(k.reshape(B, S, H2, d), k_norm_w).transpose(0, 2, 1, 3).astype(jnp.float32)
    v = v.reshape(B, S, DIFF_HEADS, DIFF_V_DIM).transpose(0, 2, 1, 3)
    lam = lambdas.astype(jnp.float32)
    lambda_full = jnp.exp(jnp.sum(lam[0] * lam[1])) - jnp.exp(jnp.sum(lam[2] * lam[3])) + lambda_init
    bias_t = rel_bias.T.astype(jnp.float32)
    kpos = jnp.arange(S)

    def block(c):
        t0 = c * QB
        t = t0 + jnp.arange(QB)
        qb = lax.dynamic_slice_in_dim(q, t0, QB, axis=2)
        dist = t[:, None] - kpos[None, :]
        s = jnp.einsum('bhqd,bhkd->bhqk', qb, k) + bias_t[:, _rel_bucket(dist)]
        s = jnp.where(dist >= 0, s, NEG)
        p = jax.nn.softmax(s, axis=-1).reshape(B, DIFF_HEADS, 2, QB, S)
        attn = p[:, :, 0] - lambda_full * p[:, :, 1]
        return jnp.einsum('bhqk,bhkv->bhqv', attn, v)

    outs = lax.map(block, jnp.arange(S // QB))
    o = outs.transpose(1, 2, 0, 3, 4).reshape(B, DIFF_HEADS, S, DIFF_V_DIM)
    o = _rmsnorm(o, subln_w) * (1.0 - lambda_init)
    o = o.transpose(0, 2, 1, 3).reshape(B, S, DIFF_HEADS * DIFF_V_DIM)
    return (o @ w_out).astype(h.dtype)


def setup_inputs(seed: int = 0) -> dict:
    key = jax.random.key(seed)
    ks = jax.random.split(key, 18)

    def nrm(k, shape, scale):
        return jax.random.normal(k, shape, jnp.float32) * scale

    D = D_MODEL
    ret_in = 2 * RET_HEADS * RET_DK + 2 * RET_HEADS * RET_DV
    return {
        "x": nrm(ks[0], (BATCH, SEQ, D), 1.0),
        "rel_bias": nrm(ks[1], (REL_BUCKETS, ATTN_HEADS), 0.5),
        "norm1": 1.0 + nrm(ks[2], (DEPTH, D), 0.02),
        "norm2": 1.0 + nrm(ks[3], (DEPTH, D), 0.02),
        "w_up": nrm(ks[4], (DEPTH, D, D_FF), D ** -0.5),
        "w_down": nrm(ks[5], (DEPTH, D_FF, D), D_FF ** -0.5),
        "ret_w_in": nrm(ks[6], (N_RET, D, ret_in), D ** -0.5),
        "ret_w_out": nrm(ks[7], (N_RET, RET_HEADS * RET_DV, D), (RET_HEADS * RET_DV) ** -0.5),
        "moba_w_in": nrm(ks[8], (N_MOBA, D, 3 * ATTN_HEADS * HEAD_DIM), D ** -0.5),
        "moba_q_norm": 1.0 + nrm(ks[9], (N_MOBA, HEAD_DIM), 0.02),
        "moba_k_norm": 1.0 + nrm(ks[10], (N_MOBA, HEAD_DIM), 0.02),
        "moba_w_out": nrm(ks[11], (N_MOBA, ATTN_HEADS * HEAD_DIM, D), (ATTN_HEADS * HEAD_DIM) ** -0.5),
        "diff_w_in": nrm(ks[12], (N_DIFF, D, 3 * ATTN_HEADS * HEAD_DIM), D ** -0.5),
        "diff_q_norm": 1.0 + nrm(ks[13], (N_DIFF, HEAD_DIM), 0.02),
        "diff_k_norm": 1.0 + nrm(ks[14], (N_DIFF, HEAD_DIM), 0.02),
        "diff_lambda": nrm(ks[15], (N_DIFF, 4, HEAD_DIM), 0.1),
        "diff_subln": 1.0 + nrm(ks[16], (N_DIFF, DIFF_V_DIM), 0.02),
        "diff_w_out": nrm(ks[17], (N_DIFF, DIFF_HEADS * DIFF_V_DIM, D), (DIFF_HEADS * DIFF_V_DIM) ** -0.5),
    }


def reference(x, rel_bias, norm1, norm2, w_up, w_down, ret_w_in, ret_w_out,
              moba_w_in, moba_q_norm, moba_k_norm, moba_w_out,
              diff_w_in, diff_q_norm, diff_k_norm, diff_lambda, diff_subln, diff_w_out):
    for i in range(DEPTH):
        kind, j = i % N_MIXERS, i // N_MIXERS
        h = _rmsnorm(x, norm1[i])
        if kind == 0:
            m = _retention_mixer(h, ret_w_in[j], ret_w_out[j])
        elif kind == 1:
            m = _moba_mixer(h, moba_w_in[j], moba_q_norm[j], moba_k_norm[j], moba_w_out[j], rel_bias)
        else:
            lambda_init = 0.8 - 0.6 * math.exp(-0.3 * i)
            m = _diff_mixer(h, diff_w_in[j], diff_q_norm[j], diff_k_norm[j], diff_lambda[j],
                            diff_subln[j], diff_w_out[j], rel_bias, lambda_init)
        x = x + m
        x = x + _squared_relu_mlp(_rmsnorm(x, norm2[i]), w_up[i], w_down[i])
    return x
```

```cpp
#include <hip/hip_runtime.h>
#include <hip/hip_bf16.h>
#include <cstdio>
#include <cstdint>

__device__ __forceinline__ int lane_now() { int l; asm volatile("v_mbcnt_lo_u32_b32 %0, -1, 0\n\tv_mbcnt_hi_u32_b32 %0, -1, %0" : "=v"(l)); return l; }

#ifndef MK_PER_PHASE
#define MK_PER_PHASE 0
#endif

namespace pg8 {
#define PG8_LAS __attribute__((address_space(3)))
typedef unsigned short bf16_t;
typedef short bf16x8 __attribute__((ext_vector_type(8)));
typedef float f32x4 __attribute__((ext_vector_type(4)));
typedef unsigned u32x4 __attribute__((ext_vector_type(4)));
constexpr int BM = 256, BK = 64, HALF = 128, HTB = HALF * BK * 2  , STAGE_BYTES = 8 * HTB, NXCD = 8, WGM = 8;

__host__ __device__ __forceinline__ int lds_byte(int r, int c) { const int st = (r >> 4) * 2 + (c >> 5), rr = r & 15, cc = c & 31, ob = rr * 64 + cc * 2; return st * 1024 + (ob ^ (((ob >> 9) & 1) << 5)); }
__host__ __device__ __forceinline__ void stage_rc(int b, int& R, int& C) { const int st = b / 1024, sb = b % 1024, swz = sb ^ (((sb >> 9) & 1) << 5); R = (st >> 1) * 16 + swz / 64; C = (st & 1) * 32 + (swz % 64) / 2; }
__host__ __device__ __forceinline__ int perm32(int rho) { const int n = rho >> 4, i = rho & 15; return 8 * (i >> 2) + 4 * n + (i & 3); }

struct Unit { const char* a0; const char* b0; const char* a1; const char* b1; int pm, pn, ty, z; };
struct GemmP { int lda, ldb, nt1, nt2; };

__host__ __device__ __forceinline__ void tile_of(int L, int nM, int nN, int& pm, int& pn) {
    const int nwg = nM * nN; int wgid = L; { const int q = nwg / NXCD, r = nwg % NXCD, xcd = wgid % NXCD, off = wgid / NXCD; wgid = (xcd < r ? xcd * (q + 1) : r * (q + 1) + (xcd - r) * q) + off; }
    const int nig = WGM * nN, gid = wgid / nig, fm = gid * WGM, gsz = (nM - fm) < WGM ? (nM - fm) : WGM;
    pm = fm + ((wgid % nig) % gsz); pn = (wgid % nig) / gsz;
}

__device__ __forceinline__ unsigned cvt_pk_bf16(float lo, float hi) { unsigned r; asm volatile("v_cvt_pk_bf16_f32 %0, %1, %2" : "=v"(r) : "v"(lo), "v"(hi)); return r; }
__device__ __forceinline__ u32x4 pack8(const f32x4 v0, const f32x4 v1) { u32x4 w; w.x = cvt_pk_bf16(v0[0], v0[1]); w.y = cvt_pk_bf16(v0[2], v0[3]); w.z = cvt_pk_bf16(v1[0], v1[1]); w.w = cvt_pk_bf16(v1[2], v1[3]); return w; }

template <class Epi, class Sched, bool ALIGN_EPI, bool SP2>
__device__ __forceinline__ void gemm_phase(PG8_LAS unsigned char* lds, const int wave, const GemmP g, const Sched& S, const Epi& E) {
    const int lane = lane_now(), wid = wave, tid = wave * 64 + lane, wr = wid >> 2, wc = wid & 3, fr = lane & 15, fq = lane >> 4;
    const int nt1 = g.nt1, nt = g.nt1 + g.nt2;
    unsigned voffA[2], voffB[2];
#pragma unroll
    for (int i = 0; i < 2; ++i) { int R, C; stage_rc(tid * 16 + i * 8192, R, C); const int Rb = Epi::PERM ? ((R & ~31) + perm32(R & 31)) : R;
        voffA[i] = (unsigned)(R * g.lda + C) * 2u; voffB[i] = (unsigned)(Rb * g.ldb + C) * 2u; }
    const size_t kstep = (size_t)(BK * 2);
    const size_t hstepA = (size_t)HALF * g.lda * 2, hstepB = (size_t)HALF * g.ldb * 2;
    const unsigned ldsw = (unsigned)wid * 1024u;
    const int aoff = lds_byte(wr * 64 + fr, fq * 8), boff = lds_byte(wc * 32 + fr, fq * 8);
#define PG8_SA(b, h) (((b) * 2 + (h)) * HTB)
#define PG8_SB(b, h) ((4 + (b) * 2 + (h)) * HTB)
#define PG8_STAGE(bufoff, gbase, voff) do { _Pragma("unroll") for (int _i = 0; _i < 2; ++_i) \
        __builtin_amdgcn_global_load_lds((const unsigned*)((const char*)(gbase) + (voff)[_i]), (PG8_LAS unsigned*)(lds + (bufoff) + ldsw + _i * 8192), 16, 0, 0); } while (0)
#define PG8_LDA(dst, b, h) do { _Pragma("unroll") for (int m = 0; m < 4; ++m) _Pragma("unroll") for (int k = 0; k < 2; ++k) dst[m][k] = *(const PG8_LAS bf16x8*)(lds + PG8_SA(b, h) + aoff + m * 2048 + k * 1024); } while (0)
#define PG8_LDB(dst, b, h) do { _Pragma("unroll") for (int n = 0; n < 2; ++n) _Pragma("unroll") for (int k = 0; k < 2; ++k) dst[n][k] = *(const PG8_LAS bf16x8*)(lds + PG8_SB(b, h) + boff + n * 2048 + k * 1024); } while (0)
#define PG8_MMA(ai, bj, At, Bt) do { __builtin_amdgcn_s_setprio(1); _Pragma("unroll") for (int m = 0; m < 4; ++m) _Pragma("unroll") for (int n = 0; n < 2; ++n) _Pragma("unroll") for (int k = 0; k < 2; ++k) \
        acc[ai][bj][m][n] = __builtin_amdgcn_mfma_f32_16x16x32_bf16(Bt[n][k], At[m][k], acc[ai][bj][m][n], 0, 0, 0); __builtin_amdgcn_s_setprio(0); } while (0)
#define PG8_WAIT_V(n) asm volatile("s_waitcnt vmcnt(" #n ")" ::: "memory")
#define PG8_WAIT_L(n) asm volatile("s_waitcnt lgkmcnt(" #n ")" ::: "memory")
#define PG8_BAR __builtin_amdgcn_s_barrier()
#define PG8_SCHED __builtin_amdgcn_sched_barrier(0)
    Unit cur, nxt; int ui = 0;
    if (!S.next(0, cur)) return;
    f32x4 acc[2][2][4][2];
#pragma unroll
    for (int a = 0; a < 2; ++a)
#pragma unroll
        for (int b = 0; b < 2; ++b)
#pragma unroll
            for (int m = 0; m < 4; ++m)
#pragma unroll
                for (int n = 0; n < 2; ++n) acc[a][b][m][n] = (f32x4){0.f, 0.f, 0.f, 0.f};
    bf16x8 At[4][2], B0[2][2], B1[2][2];
    const char* cA = cur.a0; const char* cB = cur.b0;
    if constexpr (SP2) {
        PG8_STAGE(PG8_SB(0, 0), cB, voffB); PG8_STAGE(PG8_SB(0, 1), cB + hstepB, voffB); PG8_STAGE(PG8_SA(0, 0), cA, voffA); PG8_STAGE(PG8_SA(0, 1), cA + hstepA, voffA);
        if (wr == 1) PG8_BAR;
        PG8_WAIT_V(2); PG8_BAR;
        PG8_STAGE(PG8_SB(1, 0), cB + kstep, voffB); PG8_STAGE(PG8_SA(1, 0), cA + kstep, voffA); PG8_STAGE(PG8_SB(1, 1), cB + hstepB + kstep, voffB);
        PG8_WAIT_V(6); PG8_BAR;
    } else {
        PG8_STAGE(PG8_SB(0, 0), cB, voffB); PG8_STAGE(PG8_SA(0, 0), cA, voffA); PG8_STAGE(PG8_SB(0, 1), cB + hstepB, voffB); PG8_STAGE(PG8_SA(0, 1), cA + hstepA, voffA);
        if (wr == 1) PG8_BAR;
        PG8_WAIT_V(4); PG8_BAR;
        PG8_STAGE(PG8_SB(1, 0), cB + kstep, voffB); PG8_STAGE(PG8_SA(1, 0), cA + kstep, voffA); PG8_STAGE(PG8_SB(1, 1), cB + hstepB + kstep, voffB);
        PG8_WAIT_V(6); PG8_BAR;
    }
    for (;;) {
        const bool has_next = S.next(ui + 1, nxt);
        const char* nA = has_next ? nxt.a0 : cur.a0; const char* nB = has_next ? nxt.b0 : cur.b0;
        for (int t = 0; t < nt; t += 2) {
            if constexpr (Epi::KHOOK) { if (t > 0 && (t & 7) == 0) E.khook(acc, t >> 3, wr, fr); }
            const bool last = (t == nt - 2);
            const bool s1 = (t >= nt1), s2 = (t + 2 >= nt1);
            const char* a1 = s1 ? cur.a1 + (size_t)(t + 1 - nt1) * kstep : cur.a0 + (size_t)(t + 1) * kstep;
            const char* a2 = last ? nA : (s2 ? cur.a1 + (size_t)(t + 2 - nt1) * kstep : cur.a0 + (size_t)(t + 2) * kstep);
            const char* b2 = last ? nB : (s2 ? cur.b1 + (size_t)(t + 2 - nt1) * kstep : cur.b0 + (size_t)(t + 2) * kstep);
            const char* a3 = a2 + kstep; const char* b3 = b2 + kstep;
            if constexpr (SP2) {
            PG8_LDB(B0, 0, 0); PG8_LDB(B1, 0, 1); PG8_SCHED; PG8_LDA(At, 0, 0); PG8_STAGE(PG8_SA(1, 1), a1 + hstepA, voffA);
            PG8_WAIT_V(8); PG8_WAIT_L(0); PG8_BAR; PG8_MMA(0, 0, At, B0); PG8_MMA(0, 1, At, B1); PG8_BAR; PG8_SCHED;
            PG8_LDA(At, 0, 1); PG8_STAGE(PG8_SB(0, 0), b2, voffB); PG8_STAGE(PG8_SB(0, 1), b2 + hstepB, voffB); PG8_STAGE(PG8_SA(0, 0), a2, voffA);
            PG8_WAIT_V(8); PG8_WAIT_L(0); PG8_BAR; PG8_MMA(1, 0, At, B0); PG8_MMA(1, 1, At, B1); PG8_BAR; PG8_SCHED;
            PG8_LDB(B0, 1, 0); PG8_LDB(B1, 1, 1); PG8_SCHED; PG8_LDA(At, 1, 0); PG8_STAGE(PG8_SA(0, 1), a2 + hstepA, voffA);
            PG8_WAIT_V(8); PG8_WAIT_L(0); PG8_BAR; PG8_MMA(0, 0, At, B0); PG8_MMA(0, 1, At, B1); PG8_BAR; PG8_SCHED;
            PG8_LDA(At, 1, 1); PG8_STAGE(PG8_SB(1, 0), b3, voffB); PG8_STAGE(PG8_SB(1, 1), b3 + hstepB, voffB); PG8_STAGE(PG8_SA(1, 0), a3, voffA);
            PG8_WAIT_V(8); PG8_WAIT_L(0); PG8_BAR; PG8_MMA(1, 0, At, B0); PG8_MMA(1, 1, At, B1); PG8_BAR; PG8_SCHED;
            } else {
            PG8_LDB(B0, 0, 0); PG8_SCHED; PG8_LDA(At, 0, 0); PG8_STAGE(PG8_SA(1, 1), a1 + hstepA, voffA);
            PG8_WAIT_L(8); PG8_BAR; PG8_WAIT_L(0); PG8_MMA(0, 0, At, B0); PG8_BAR; PG8_SCHED;
            PG8_LDB(B1, 0, 1); PG8_STAGE(PG8_SB(0, 0), b2, voffB);
            PG8_BAR; PG8_WAIT_L(0); PG8_MMA(0, 1, At, B1); PG8_BAR;
            PG8_LDA(At, 0, 1); PG8_STAGE(PG8_SA(0, 0), a2, voffA);
            PG8_BAR; PG8_WAIT_L(0); PG8_MMA(1, 0, At, B0); PG8_BAR; PG8_SCHED;
            PG8_STAGE(PG8_SB(0, 1), b2 + hstepB, voffB);
            PG8_WAIT_V(6); PG8_BAR; PG8_MMA(1, 1, At, B1); PG8_BAR;
            PG8_LDB(B0, 1, 0); PG8_SCHED; PG8_LDA(At, 1, 0); PG8_STAGE(PG8_SA(0, 1), a2 + hstepA, voffA);
            PG8_WAIT_L(8); PG8_BAR; PG8_WAIT_L(0); PG8_MMA(0, 0, At, B0); PG8_BAR; PG8_SCHED;
            PG8_LDB(B1, 1, 1); PG8_STAGE(PG8_SB(1, 0), b3, voffB);
            PG8_BAR; PG8_WAIT_L(0); PG8_MMA(0, 1, At, B1); PG8_BAR;
            PG8_LDA(At, 1, 1); PG8_STAGE(PG8_SA(1, 0), a3, voffA);
            PG8_BAR; PG8_WAIT_L(0); PG8_MMA(1, 0, At, B0); PG8_BAR; PG8_SCHED;
            PG8_STAGE(PG8_SB(1, 1), b3 + hstepB, voffB);
            PG8_WAIT_V(6); PG8_BAR; PG8_MMA(1, 1, At, B1); PG8_BAR;
            }
        }
        if constexpr (ALIGN_EPI) { if (wr == 0) PG8_BAR; }
        E(acc, cur, wr, wc, fr, fq);
        if (!has_next) break;
#pragma unroll
        for (int a = 0; a < 2; ++a)
#pragma unroll
            for (int b = 0; b < 2; ++b)
#pragma unroll
                for (int m = 0; m < 4; ++m)
#pragma unroll
                    for (int n = 0; n < 2; ++n) acc[a][b][m][n] = (f32x4){0.f, 0.f, 0.f, 0.f};
        cur = nxt; ++ui;
        if constexpr (ALIGN_EPI) { if (wr == 1) PG8_BAR; }
    }
    PG8_WAIT_V(0);
    if constexpr (!ALIGN_EPI) { if (wr == 0) PG8_BAR; }
    PG8_BAR;
#undef PG8_SA
#undef PG8_SB
#undef PG8_STAGE
#undef PG8_LDA
#undef PG8_LDB
#undef PG8_MMA
#undef PG8_WAIT_V
#undef PG8_WAIT_L
#undef PG8_BAR
#undef PG8_SCHED
}
}

constexpr int NWAVES = 8;
constexpr int BATCH = 4, SEQ = 4096, D = 1024, FF = 4096, M = BATCH * SEQ;
constexpr int RH = 4, RDK = 256, RDV = 512, RIN = 2 * RH * RDK + 2 * RH * RDV  , RCH = 256  , RNC = SEQ / RCH  ;
constexpr int AH = 16, HD = 64;
constexpr float EPS = 1e-6f;
constexpr float LOG2E = 1.4426950408889634f;

constexpr size_t MiB = 1u << 20;
constexpr size_t WS_CTL = 0, CTL_ZERO_BYTES = 1 * MiB;
constexpr size_t WS_W = 1 * MiB;
constexpr size_t WS_WIN = WS_W, WS_WOUT = WS_W + 16 * MiB, WS_WUP = WS_W, WS_WDN = WS_W + 8 * MiB;
constexpr size_t WS_KM = 21 * MiB;
constexpr size_t WS_RN = 21 * MiB + 512 * 1024;
constexpr size_t WS_SQ = 22 * MiB;
constexpr size_t WS_SS = 23 * MiB;
constexpr size_t WS_BIG = 25 * MiB;
constexpr size_t WS_H = WS_BIG;
constexpr size_t WS_U = WS_BIG + 32 * MiB;
constexpr size_t WS_QT = WS_BIG + 32 * MiB, WS_KTK = WS_BIG + 64 * MiB, WS_P = WS_KTK  , WS_KF = WS_BIG + 96 * MiB, WS_VT = WS_BIG + 128 * MiB, WS_G = WS_BIG + 192 * MiB;
constexpr size_t WS_AQ = WS_BIG + 32 * MiB, WS_AK = WS_BIG + 64 * MiB, WS_AV = WS_BIG + 96 * MiB, WS_OB = WS_BIG + 128 * MiB, WS_Y = WS_AQ;
constexpr size_t WS_END = WS_BIG + 256 * MiB;
constexpr int CW_TMO = 0, CW_BAR = 4096;

constexpr int RING_OFF = 0, RING_BYTES = 131072;
constexpr int LDSCTL_OFF = RING_BYTES, MISC_OFF = LDSCTL_OFF + 320;
constexpr int LDS_BYTES = 163840;

#define GAS __attribute__((address_space(1)))
#define LAS __attribute__((address_space(3)))
typedef unsigned short bf16;
typedef unsigned v4u __attribute__((ext_vector_type(4)));
typedef unsigned v2u __attribute__((ext_vector_type(2)));
typedef float f32x4 __attribute__((ext_vector_type(4)));
typedef GAS unsigned gu32;
#define RLX_AGENT __ATOMIC_RELAXED, __HIP_MEMORY_SCOPE_AGENT
#define LDS_WAIT() asm volatile("s_waitcnt lgkmcnt(0)" ::: "memory")
#define VM_WAIT() asm volatile("s_waitcnt vmcnt(0)" ::: "memory")
__device__ __forceinline__ unsigned f2bf(float f) { unsigned u = __builtin_bit_cast(unsigned, f); return (u + 0x7fffu + ((u >> 16) & 1u)) >> 16; }
__device__ __forceinline__ unsigned pk2(float lo, float hi) { return f2bf(lo) | (f2bf(hi) << 16); }
__device__ __forceinline__ float bflo(unsigned w) { return __builtin_bit_cast(float, w << 16); }
__device__ __forceinline__ float bfhi(unsigned w) { return __builtin_bit_cast(float, w & 0xffff0000u); }
__device__ __forceinline__ float wave_sum(float v) {
#pragma unroll
    for (int o = 1; o < 64; o <<= 1) v += __shfl_xor(v, o);
    return v;
}

namespace pg8 {
__device__ __forceinline__ float row16_sum(float v) {
    v += __builtin_bit_cast(float, __builtin_amdgcn_update_dpp(0, __builtin_bit_cast(int, v), 0xB1, 0xF, 0xF, true));
    v += __builtin_bit_cast(float, __builtin_amdgcn_update_dpp(0, __builtin_bit_cast(int, v), 0x4E, 0xF, 0xF, true));
    v += __builtin_bit_cast(float, __builtin_amdgcn_update_dpp(0, __builtin_bit_cast(int, v), 0x141, 0xF, 0xF, true));
    v += __builtin_bit_cast(float, __builtin_amdgcn_update_dpp(0, __builtin_bit_cast(int, v), 0x140, 0xF, 0xF, true));
    return v;
}
struct EpiRetIn {
    static constexpr bool PERM = true, KHOOK = false;
    bf16_t *QT, *KTK, *KF, *VT, *G; const PG8_LAS float* RN; PG8_LAS unsigned char* tsc;
    __device__ __forceinline__ void operator()(f32x4 (&acc)[2][2][4][2], const Unit& u, int wr, int wc, int fr, int fq) const {
        asm volatile("" : "+v"(fr), "+v"(fq));
        const float RL = 13.287712379549449f / 128.f, I2PI = 0.15915494309189535f;
        if (u.ty == 2) {
            bf16_t* base = G + (size_t)(u.pm * 256 + wr * 64 + fr) * 2048 + (u.pn - 8) * 256 + wc * 32 + 8 * fq;
#pragma unroll
            for (int ai = 0; ai < 2; ++ai)
#pragma unroll
                for (int m = 0; m < 4; ++m) { const float rn = RN[u.z * 256 + ai * 128 + wr * 64 + m * 16 + fr];
#pragma unroll
                    for (int bj = 0; bj < 2; ++bj) *(u32x4*)(base + (size_t)(ai * 128 + m * 16) * 2048 + bj * 128) = pack8(acc[ai][bj][m][0] * rn, acc[ai][bj][m][1] * rn); }
        } else if (u.ty == 4) {
            const int vt = u.pm, h = vt >> 1, half = vt & 1, b = u.pn >> 4, nc = u.pn & 15;
            bf16_t* base = VT + ((size_t)(((b * 4 + h) * 16 + nc) * 512 + half * 256 + wr * 64 + fr)) * 256 + wc * 32 + 8 * fq;
            f32x4 rc[2][2];
#pragma unroll
            for (int bj = 0; bj < 2; ++bj)
#pragma unroll
                for (int n = 0; n < 2; ++n) rc[bj][n] = *(const PG8_LAS f32x4*)(RN + u.z * 256 + bj * 128 + wc * 32 + 8 * fq + 4 * n);
#pragma unroll
            for (int ai = 0; ai < 2; ++ai)
#pragma unroll
                for (int m = 0; m < 4; ++m)
#pragma unroll
                    for (int bj = 0; bj < 2; ++bj) *(u32x4*)(base + (size_t)(ai * 128 + m * 16) * 256 + bj * 128) = pack8(acc[ai][bj][m][0] * rc[bj][0], acc[ai][bj][m][1] * rc[bj][1]);
        } else {
            const int h = u.pn & 3, b = u.pm >> 4;
            const float lg = __builtin_amdgcn_logf(1.0f - __builtin_amdgcn_exp2f(-5.0f - (float)h));
            float fi[2][4];
#pragma unroll
            for (int n = 0; n < 2; ++n)
#pragma unroll
                for (int j = 0; j < 4; ++j) fi[n][j] = __builtin_amdgcn_exp2f(-(float)(wc * 32 + 8 * fq + 4 * n + j) * RL) * I2PI;
            bf16_t* base = (u.ty == 0 ? QT : KTK) + (size_t)(b * 4 + h) * 4096 * 256 + wc * 32 + 8 * fq;
#pragma unroll
            for (int ai = 0; ai < 2; ++ai)
#pragma unroll
                for (int m = 0; m < 4; ++m) {
                    const int posi = (u.pm & 15) * 256 + ai * 128 + wr * 64 + m * 16 + fr, p = posi & 255; const float pos = (float)posi;
                    const float dec = ((u.ty == 0) ? __builtin_amdgcn_exp2f((float)p * lg) : 0.0625f * __builtin_amdgcn_exp2f(-(float)p * lg)) * RN[u.z * 256 + ai * 128 + wr * 64 + m * 16 + fr];
                    f32x4 y1[2], y2[2];
#pragma unroll
                    for (int n = 0; n < 2; ++n)
#pragma unroll
                        for (int j = 0; j < 4; ++j) {
                            const float rev = __builtin_amdgcn_fractf(pos * fi[n][j]); const float c = __builtin_amdgcn_cosf(rev), s = __builtin_amdgcn_sinf(rev);
                            const float x1 = acc[ai][0][m][n][j], x2 = acc[ai][1][m][n][j];
                            y1[n][j] = (x1 * c - x2 * s) * dec; y2[n][j] = (x1 * s + x2 * c) * dec; }
                    const u32x4 w1 = pack8(y1[0], y1[1]), w2 = pack8(y2[0], y2[1]);
                    *(u32x4*)(base + (size_t)posi * 256) = w1;
                    *(u32x4*)(base + (size_t)posi * 256 + 128) = w2;
                    if (u.ty == 1) {
                        PG8_LAS unsigned char* sc = tsc + (wr * 4 + wc) * 2048;
                        *(PG8_LAS u32x4*)(sc + fr * 64 + fq * 16) = w1; *(PG8_LAS u32x4*)(sc + 1024 + fr * 64 + fq * 16) = w2;
                        asm volatile("s_waitcnt lgkmcnt(0)" ::: "memory");
                        const int c = (fq & 1) * 16 + fr, o = fq >> 1; unsigned t1[4], t2[4];
#pragma unroll
                        for (int q = 0; q < 4; ++q) {
                            t1[q] = (unsigned)*(const PG8_LAS unsigned short*)(sc + (8 * o + 2 * q) * 64 + 2 * c) | ((unsigned)*(const PG8_LAS unsigned short*)(sc + (8 * o + 2 * q + 1) * 64 + 2 * c) << 16);
                            t2[q] = (unsigned)*(const PG8_LAS unsigned short*)(sc + 1024 + (8 * o + 2 * q) * 64 + 2 * c) | ((unsigned)*(const PG8_LAS unsigned short*)(sc + 1024 + (8 * o + 2 * q + 1) * 64 + 2 * c) << 16); }
                        bf16_t* kf = KF + ((size_t)(((b * 4 + h) * 16 + (u.pm & 15)) * 256 + wc * 32 + c)) * 256 + ai * 128 + wr * 64 + m * 16 + 8 * o;
                        *(u32x4*)kf = (u32x4){t1[0], t1[1], t1[2], t1[3]}; *(u32x4*)(kf + (size_t)128 * 256) = (u32x4){t2[0], t2[1], t2[2], t2[3]};
                        asm volatile("s_waitcnt lgkmcnt(0)" ::: "memory");
                    }
                    __builtin_amdgcn_sched_barrier(0);
                }
        }
    }
};
struct EpiMask {
    static constexpr bool PERM = true, KHOOK = false;
    bf16_t* P;
    __device__ __forceinline__ void operator()(f32x4 (&acc)[2][2][4][2], const Unit& u, int wr, int wc, int fr, int fq) const {
        asm volatile("" : "+v"(fr), "+v"(fq));
        bf16_t* base = P + ((size_t)u.z * 4096 + u.pm * 256 + wr * 64 + fr) * 256 + wc * 32 + 8 * fq;
#pragma unroll
        for (int ai = 0; ai < 2; ++ai)
#pragma unroll
            for (int m = 0; m < 4; ++m) { const int r = ai * 128 + wr * 64 + m * 16 + fr;
#pragma unroll
                for (int bj = 0; bj < 2; ++bj) { f32x4 v0 = acc[ai][bj][m][0], v1 = acc[ai][bj][m][1]; const int c0 = bj * 128 + wc * 32 + 8 * fq;
#pragma unroll
                    for (int j = 0; j < 4; ++j) { if (c0 + j > r) v0[j] = 0.f; if (c0 + 4 + j > r) v1[j] = 0.f; }
                    *(u32x4*)(base + (size_t)(ai * 128 + m * 16) * 256 + bj * 128) = pack8(v0, v1); } }
    }
};
struct EpiState {
    static constexpr bool PERM = true, KHOOK = false;
    bf16_t* ST;
    __device__ __forceinline__ void operator()(f32x4 (&acc)[2][2][4][2], const Unit& u, int wr, int wc, int fr, int fq) const {
        asm volatile("" : "+v"(fr), "+v"(fq));
        bf16_t* base = ST + ((size_t)u.z * 512 + u.pn * 256 + wr * 64 + fr) * 256 + wc * 32 + 8 * fq;
#pragma unroll
        for (int ai = 0; ai < 2; ++ai)
#pragma unroll
            for (int m = 0; m < 4; ++m)
#pragma unroll
                for (int bj = 0; bj < 2; ++bj) *(u32x4*)(base + (size_t)(ai * 128 + m * 16) * 256 + bj * 128) = pack8(acc[ai][bj][m][0], acc[ai][bj][m][1]);
    }
};
struct EpiMaskState {
    static constexpr bool PERM = true, KHOOK = false;
    EpiMask em; EpiState es;
    __device__ __forceinline__ void operator()(f32x4 (&acc)[2][2][4][2], const Unit& u, int wr, int wc, int fr, int fq) const { if (u.ty == 0) em(acc, u, wr, wc, fr, fq); else es(acc, u, wr, wc, fr, fq); }
};
struct EpiRetOut {
    static constexpr bool PERM = true, KHOOK = false;
    bf16_t* G; float* SS;
    __device__ __forceinline__ void operator()(f32x4 (&acc)[2][2][4][2], const Unit& u, int wr, int wc, int fr, int fq) const {
        asm volatile("" : "+v"(fr), "+v"(fq));
        const int h = u.z, half = u.pn;
        bf16_t* base = G + (size_t)(u.pm * 256 + wr * 64 + fr) * 2048 + h * 512 + half * 256 + wc * 32 + 8 * fq;
#pragma unroll
        for (int am = 0; am < 4; ++am) { const int ai = am >> 1;
            u32x4 gall[4][2];
#pragma unroll
            for (int m = 2 * (am & 1); m < 2 * (am & 1) + 2; ++m)
#pragma unroll
                for (int bj = 0; bj < 2; ++bj) gall[m][bj] = *(const u32x4*)(base + (size_t)(ai * 128 + m * 16) * 2048 + bj * 128);
            __builtin_amdgcn_sched_barrier(0);
#pragma unroll
            for (int m = 2 * (am & 1); m < 2 * (am & 1) + 2; ++m) {
                const int tok = u.pm * 256 + ai * 128 + wr * 64 + m * 16 + fr;
                float ss = 0.f;
#pragma unroll
                for (int bj = 0; bj < 2; ++bj)
#pragma unroll
                    for (int n = 0; n < 2; ++n) { const f32x4 x = acc[ai][bj][m][n]; ss += (x[0] * x[0] + x[1] * x[1]) + (x[2] * x[2] + x[3] * x[3]); }
                ss += __shfl_xor(ss, 16); ss += __shfl_xor(ss, 32);
                if (fq == 0) SS[((size_t)(tok * 4 + h) * 2 + half) * 4 + wc] = ss;
#pragma unroll
                for (int bj = 0; bj < 2; ++bj) {
                    bf16_t* p = base + (size_t)(ai * 128 + m * 16) * 2048 + bj * 128;
                    const u32x4 gw = gall[m][bj]; f32x4 v0 = acc[ai][bj][m][0], v1 = acc[ai][bj][m][1];
                    float gv[8] = {bflo(gw.x), bfhi(gw.x), bflo(gw.y), bfhi(gw.y), bflo(gw.z), bfhi(gw.z), bflo(gw.w), bfhi(gw.w)};
#pragma unroll
                    for (int j = 0; j < 4; ++j) { const float g0 = gv[j], g1 = gv[4 + j];
                        v0[j] *= g0 * __builtin_amdgcn_rcpf(1.0f + __builtin_amdgcn_exp2f(-g0 * 1.4426950408889634f));
                        v1[j] *= g1 * __builtin_amdgcn_rcpf(1.0f + __builtin_amdgcn_exp2f(-g1 * 1.4426950408889634f)); }
                    *(u32x4*)p = pack8(v0, v1); }
            }
        }
    }
};
#define PG8_RES_BODY(SCALE) \
        const size_t off0 = (size_t)(u.pm * 256 + wr * 64 + fr) * 1024 + u.pn * 256 + wc * 32 + 8 * fq; \
        _Pragma("unroll") for (int ai = 0; ai < 2; ++ai) { \
            u32x4 xw[4][2];     \
            _Pragma("unroll") for (int m = 0; m < 4; ++m) \
                _Pragma("unroll") for (int bj = 0; bj < 2; ++bj) xw[m][bj] = *(const u32x4*)(XB + off0 + (size_t)(ai * 128 + m * 16) * 1024 + bj * 128); \
            __builtin_amdgcn_sched_barrier(0); \
            _Pragma("unroll") for (int m = 0; m < 4; ++m) { const size_t off = off0 + (size_t)(ai * 128 + m * 16) * 1024; \
                float ss = 0.f; SCALE \
                _Pragma("unroll") for (int bj = 0; bj < 2; ++bj) { const u32x4 bw = xw[m][bj]; \
                    const f32x4 b0 = (f32x4){bflo(bw.x), bfhi(bw.x), bflo(bw.y), bfhi(bw.y)}, b1 = (f32x4){bflo(bw.z), bfhi(bw.z), bflo(bw.w), bfhi(bw.w)}; \
                    const f32x4 o0 = b0 + acc[ai][bj][m][0] * r3, o1 = b1 + acc[ai][bj][m][1] * r3; \
                    if (LAST) { *(f32x4*)(out + off + bj * 128) = o0; *(f32x4*)(out + off + bj * 128 + 4) = o1; } \
                    else { ss += ((o0[0] * o0[0] + o0[1] * o0[1]) + (o0[2] * o0[2] + o0[3] * o0[3])) + ((o1[0] * o1[0] + o1[1] * o1[1]) + (o1[2] * o1[2] + o1[3] * o1[3])); \
                        *(u32x4*)(XB + off + bj * 128) = pack8(o0, o1); } } \
                if (!LAST) { ss += __shfl_xor(ss, 16); ss += __shfl_xor(ss, 32); \
                    if (fq == 0) lsq[(ai * 128 + wr * 64 + m * 16 + fr) * 4 + wc] = ss; } \
                __builtin_amdgcn_sched_barrier(0); } } \
        if (!LAST) { asm volatile("s_waitcnt lgkmcnt(0)" ::: "memory"); __builtin_amdgcn_s_barrier(); asm volatile("" ::: "memory");     \
            const int t = (wr * 4 + wc) * 64 + fq * 16 + fr; if (t < 256) { const f32x4 p = *(const PG8_LAS f32x4*)(lsq + t * 4); SQ[(size_t)(u.pm * 256 + t) * 4 + u.pn] = (p[0] + p[1]) + (p[2] + p[3]); } }
template <bool LAST>
struct EpiRes {
    static constexpr bool PERM = true, KHOOK = false;
    bf16_t* XB; float* out; float* SQ; PG8_LAS float* lsq;
    __device__ __forceinline__ void operator()(f32x4 (&acc)[2][2][4][2], const Unit& u, int wr, int wc, int fr, int fq) const {
        asm volatile("" : "+v"(fr), "+v"(fq));
        PG8_RES_BODY(const float r3 = 1.0f;)
    }
};
struct EpiResH {
    static constexpr bool PERM = true, KHOOK = true, LAST = false;
    bf16_t* XB; float* out; float* SQ; PG8_LAS float* lsq; const PG8_LAS float* RAT;
    __device__ __forceinline__ void khook(f32x4 (&acc)[2][2][4][2], int hb, int wr, int) const {
        const int fr = lane_now() & 15;
#pragma unroll
        for (int ai = 0; ai < 2; ++ai)
#pragma unroll
            for (int m = 0; m < 4; ++m) { const float f = RAT[(hb - 1) * 256 + ai * 128 + wr * 64 + m * 16 + fr];
#pragma unroll
                for (int bj = 0; bj < 2; ++bj)
#pragma unroll
                    for (int n = 0; n < 2; ++n) acc[ai][bj][m][n] *= f;
                __builtin_amdgcn_sched_barrier(0); }
    }
    __device__ __forceinline__ void operator()(f32x4 (&acc)[2][2][4][2], const Unit& u, int wr, int wc, int fr, int fq) const {
        asm volatile("" : "+v"(fr), "+v"(fq));
        PG8_RES_BODY(const float r3 = RAT[3 * 256 + ai * 128 + wr * 64 + m * 16 + fr];)
    }
};
struct EpiUp {
    static constexpr bool PERM = true, KHOOK = false;
    bf16_t* U; const PG8_LAS float* R2;
    __device__ __forceinline__ void operator()(f32x4 (&acc)[2][2][4][2], const Unit& u, int wr, int wc, int fr, int fq) const {
        asm volatile("" : "+v"(fr), "+v"(fq));
        bf16_t* base = U + (size_t)(u.pm * 256 + wr * 64 + fr) * 4096 + u.pn * 256 + wc * 32 + 8 * fq;
#pragma unroll
        for (int ai = 0; ai < 2; ++ai)
#pragma unroll
            for (int m = 0; m < 4; ++m) {
                const float r2 = R2[u.z * 256 + ai * 128 + wr * 64 + m * 16 + fr];
#pragma unroll
                for (int bj = 0; bj < 2; ++bj) { f32x4 v0 = acc[ai][bj][m][0], v1 = acc[ai][bj][m][1];
#pragma unroll
                    for (int j = 0; j < 4; ++j) { const float a = __builtin_fmaxf(v0[j], 0.f), b = __builtin_fmaxf(v1[j], 0.f); v0[j] = a * a * r2; v1[j] = b * b * r2; }
                    *(u32x4*)(base + (size_t)(ai * 128 + m * 16) * 4096 + bj * 128) = pack8(v0, v1); } }
    }
};
template <bool MOBA>
struct EpiQKNorm {
    static constexpr bool PERM = true, KHOOK = false;
    bf16_t *Q, *K, *V; const float *qw, *kw; const PG8_LAS float* RN; bf16_t* KM; PG8_LAS float* cls;
    __device__ __forceinline__ void operator()(f32x4 (&acc)[2][2][4][2], const Unit& u, int wr, int wc, int fr, int fq) const {
        asm volatile("" : "+v"(fr), "+v"(fq));
        const int row0 = u.pm * 256 + wr * 64 + fr;
        float rnv[2][4];
#pragma unroll
        for (int ai = 0; ai < 2; ++ai)
#pragma unroll
            for (int m = 0; m < 4; ++m) rnv[ai][m] = RN[u.z * 256 + ai * 128 + wr * 64 + m * 16 + fr];
        if (u.pn >= 8) {
            bf16_t* base = V + (size_t)row0 * 1024 + (u.pn - 8) * 256 + wc * 32 + 8 * fq;
#pragma unroll
            for (int ai = 0; ai < 2; ++ai)
#pragma unroll
                for (int m = 0; m < 4; ++m) { const float rn = rnv[ai][m];
#pragma unroll
                    for (int bj = 0; bj < 2; ++bj) *(u32x4*)(base + (size_t)(ai * 128 + m * 16) * 1024 + bj * 128) = pack8(acc[ai][bj][m][0] * rn, acc[ai][bj][m][1] * rn); }
        } else {
            const bool isq = u.pn < 4; const float* w = isq ? qw : kw; const float sc = isq ? 0.125f * 1.4426950408889634f : 1.0f;
            f32x4 wv[2][2];
#pragma unroll
            for (int bj = 0; bj < 2; ++bj)
#pragma unroll
                for (int n = 0; n < 2; ++n) wv[bj][n] = *(const f32x4*)(w + 32 * bj + 8 * fq + 4 * n);
            bf16_t* base = (isq ? Q : K) + (size_t)row0 * 1024 + ((u.pn & 3) * 4 + wc) * 64 + 8 * fq;
#pragma unroll
            for (int ai = 0; ai < 2; ++ai)
#pragma unroll
                for (int m = 0; m < 4; ++m) {
                    float ss = 0.f; const float rn = rnv[ai][m];
#pragma unroll
                    for (int bj = 0; bj < 2; ++bj)
#pragma unroll
                        for (int n = 0; n < 2; ++n) { acc[ai][bj][m][n] *= rn; const f32x4 x = acc[ai][bj][m][n]; ss += (x[0] * x[0] + x[1] * x[1]) + (x[2] * x[2] + x[3] * x[3]); }
                    ss += __shfl_xor(ss, 16); ss += __shfl_xor(ss, 32);
                    const float r = __builtin_amdgcn_rsqf(ss * (1.0f / 64.0f) + 1e-6f) * sc;
#pragma unroll
                    for (int bj = 0; bj < 2; ++bj) { const f32x4 v0 = acc[ai][bj][m][0] * r * wv[bj][0], v1 = acc[ai][bj][m][1] * r * wv[bj][1];
                        *(u32x4*)(base + (size_t)(ai * 128 + m * 16) * 1024 + bj * 32) = pack8(v0, v1);
                        if constexpr (MOBA) { if (!isq) {
                            f32x4 s0 = v0, s1 = v1;
#pragma unroll
                            for (int j = 0; j < 4; ++j) { s0[j] = row16_sum(s0[j]); s1[j] = row16_sum(s1[j]); }
                            if (fr == 0) { PG8_LAS f32x4* p = (PG8_LAS f32x4*)(cls + (wr * 4 + wc) * 64 + bj * 32 + 8 * fq); p[0] = p[0] + s0; p[1] = p[1] + s1; } } } }
                }
            if constexpr (MOBA) { if (!isq) {
                asm volatile("s_waitcnt lgkmcnt(0)" ::: "memory"); __builtin_amdgcn_s_barrier(); asm volatile("" ::: "memory");
                const int t = (wr * 4 + wc) * 64 + fq * 16 + fr;
                if (t < 256) { const float sm = cls[t] + cls[256 + t];
                    KM[((size_t)((u.pm >> 4) * 64 + (u.pm & 15))) * 1024 + (u.pn & 3) * 256 + t] = (bf16_t)(cvt_pk_bf16(sm * (1.f / 256.f), 0.f) & 0xffffu);
                    cls[t] = 0.f; cls[256 + t] = 0.f; }
            } }
        }
    }
};

struct SchedPlain {
    const char* A; const char* Bt; int nM, nN, G, c; size_t ta, tb;
    __device__ __forceinline__ bool next(int i, Unit& u) const {
        const long L = (long)i * G + c; if (L >= (long)nM * nN) return false;
        int pm, pn; tile_of((int)L, nM, nN, pm, pn); u.pm = pm; u.pn = pn; u.ty = 0; u.z = i;
        u.a0 = A + (size_t)pm * ta; u.b0 = Bt + (size_t)pn * tb; u.a1 = u.a0; u.b1 = u.b0; return true;
    }
};
struct SchedRetIn {
    const char* H; const char* W; int G, c;
    __device__ __forceinline__ bool next(int i, Unit& u) const {
        const long L = (long)i * G + c; if (L >= 1536) return false;
        int pm, pn; u.z = i;
        if (L < 1024) { tile_of((int)L, 64, 16, pm, pn); u.ty = pn < 4 ? 0 : (pn < 8 ? 1 : 2);
            u.a0 = H + (size_t)pm * (256 * 1024 * 2); u.b0 = W + (size_t)(pn < 8 ? pn : pn + 8) * (256 * 1024 * 2); }
        else { tile_of((int)L - 1024, 8, 64, pm, pn); u.ty = 4;
            u.a0 = W + (size_t)(pm + 8) * (256 * 1024 * 2); u.b0 = H + (size_t)pn * (256 * 1024 * 2); }
        u.pm = pm; u.pn = pn; u.a1 = u.a0; u.b1 = u.b0; return true;
    }
};
struct SchedRetP {
    const char* QT; const char* KTK; int G, c;
    __device__ __forceinline__ bool next(int i, Unit& u) const {
        const long L = (long)i * G + c; if (L >= 256) return false;
        const int bh = (int)L >> 4, nc = (int)L & 15; u.z = bh; u.pm = nc; u.pn = 0; u.ty = 0;
        const size_t off = ((size_t)bh * 4096 + nc * 256) * 256 * 2; u.a0 = QT + off; u.b0 = KTK + off; u.a1 = u.a0; u.b1 = u.b0; return true;
    }
};
struct SchedRetPS {
    const char* QT; const char* KTK; const char* VT; const char* KF; int G, c;
    __device__ __forceinline__ bool next(int i, Unit& u) const {
        const long L = (long)i * G + c; if (L >= 768) return false;
        if (L < 256) { const int bh = (int)L >> 4, nc = (int)L & 15; u.z = bh; u.pm = nc; u.pn = 0; u.ty = 0;
            const size_t off = ((size_t)bh * 4096 + nc * 256) * 256 * 2; u.a0 = QT + off; u.b0 = KTK + off; }
        else { const int l2 = (int)L - 256, half = l2 & 1, nc = (l2 >> 1) & 15, bh = l2 >> 5; u.z = bh * 16 + nc; u.pn = half; u.pm = 0; u.ty = 1;
            u.a0 = VT + ((size_t)(bh * 16 + nc) * 512 + half * 256) * 256 * 2; u.b0 = KF + (size_t)(bh * 16 + nc) * 256 * 256 * 2; }
        u.a1 = u.a0; u.b1 = u.b0; return true;
    }
};
struct SchedRetO {
    const char* P; const char* QT; const char* VT; const char* ST; int G, c;
    __device__ __forceinline__ bool next(int i, Unit& u) const {
        const long L = (long)i * G + c; if (L >= 512) return false;
        const int half = (int)L & 1, nc = ((int)L >> 1) & 15, bh = (int)L >> 5;
        u.z = bh & 3; u.pn = half; u.pm = (bh >> 2) * 16 + nc; u.ty = 0;
        const size_t offa = ((size_t)bh * 4096 + nc * 256) * 256 * 2;
        u.a0 = P + offa; u.a1 = QT + offa;
        u.b0 = VT + ((size_t)(bh * 16 + nc) * 512 + half * 256) * 256 * 2; u.b1 = ST + ((size_t)(bh * 16 + nc) * 512 + half * 256) * 256 * 2; return true;
    }
};
}

namespace attn_body {
using bf16 = __hip_bfloat16;
using bf16x8 = __attribute__((ext_vector_type(8))) short;
using s16x4 = __attribute__((ext_vector_type(4))) short;
using f32x16 = __attribute__((ext_vector_type(16))) float;
using u32x4 = __attribute__((ext_vector_type(4))) unsigned;
constexpr int D = 64;
constexpr int NW = 8, QBLK = 32, QB = QBLK * NW, KVBLK = 64;
__device__ __forceinline__ int crow(int r, int hi) { return (r & 3) + 8 * (r >> 2) + 4 * hi; }
#define SBAR() __builtin_amdgcn_sched_barrier(0)
__device__ __forceinline__ void cmask(f32x16& p0, f32x16& p1, int jb, int qrel, int hi) {
  const float NEG = -INFINITY; int kb = 64 * jb + 4 * hi; asm volatile("" : "+v"(kb), "+v"(qrel));
  #pragma unroll
  for (int r = 0; r < 16; ++r) { int kv = kb + (r & 3) + 8 * (r >> 2); if (kv > qrel) p0[r] = NEG; if (kv + 32 > qrel) p1[r] = NEG; }
}
constexpr int NSLOT = 3, SLOTB = 8192;
constexpr int LDS_K = 0, LDS_V = NSLOT * SLOTB, LDS_WS = 2 * NSLOT * SLOTB, LDS_OST = LDS_WS + NW * 64 * 4, LDS_BYTES = LDS_OST + NW * 4096;
constexpr int LDS_TAB = 86016, TAB_N = 4096 + 256;
__device__ __forceinline__ void glds16(const void* gsrc, unsigned lds_dst) { unsigned keep;
  asm volatile("s_mov_b32 %0, m0\n\ts_mov_b32 m0, %2\n\ts_nop 0\n\tglobal_load_lds_dwordx4 %1, off\n\ts_mov_b32 m0, %0" : "=&s"(keep) : "v"(gsrc), "s"(lds_dst) : "memory"); }
__device__ __forceinline__ void glds16s(const void* sbase, unsigned voff, unsigned lds_dst) { unsigned keep;
  asm volatile("s_mov_b32 %0, m0\n\ts_mov_b32 m0, %3\n\ts_nop 4\n\tglobal_load_lds_dwordx4 %1, %2\n\ts_mov_b32 m0, %0" : "=&s"(keep) : "v"(voff), "s"(sbase), "s"(lds_dst) : "memory"); }
__device__ __forceinline__ float max3f(float a, float b, float c) { float r; asm("v_max3_f32 %0, %1, %2, %3" : "=v"(r) : "v"(a), "v"(b), "v"(c)); return r; }
__device__ __forceinline__ float max2f(float a, float b) { float r; asm("v_max_f32_e32 %0, %1, %2" : "=v"(r) : "v"(a), "v"(b)); return r; }
__device__ __forceinline__ float fadd_s(float a, float b) { float r; asm("v_add_f32_e32 %0, %1, %2" : "=v"(r) : "v"(a), "v"(b)); return r; }
__device__ __forceinline__ float fsub_s(float a, float b) { float r; asm("v_sub_f32_e32 %0, %1, %2" : "=v"(r) : "v"(a), "v"(b)); return r; }
typedef float f32x2_t __attribute__((ext_vector_type(2))); typedef __bf16 bf16x2_t __attribute__((ext_vector_type(2)));
__device__ __forceinline__ unsigned cvtpk_s(float lo, float hi) { f32x2_t v = {lo, hi}; bf16x2_t b = __builtin_convertvector(v, bf16x2_t); return __builtin_bit_cast(unsigned, b); }
#define WAIT_BAR(N) asm volatile("s_waitcnt vmcnt(" #N ") lgkmcnt(0)\n\ts_barrier" ::: "memory")

__device__ __forceinline__ void qkt(f32x16& p0, f32x16& p1, const char* Kslot, const bf16x8* qr, const f32x16& negm, int r32, int hi) {
  const char* kb = Kslot + hi * 1024 + r32 * 16;
  #pragma unroll
  for (int d0 = 0; d0 < 4; ++d0) {
    const bf16x8 b0 = *reinterpret_cast<const bf16x8*>(kb + d0 * 2048);
    const bf16x8 b1 = *reinterpret_cast<const bf16x8*>(kb + d0 * 2048 + 512);
    if (d0 == 0) { p0 = __builtin_amdgcn_mfma_f32_32x32x16_bf16(b0, qr[0], negm, 0, 0, 0); p1 = __builtin_amdgcn_mfma_f32_32x32x16_bf16(b1, qr[0], negm, 0, 0, 0); }
    else { p0 = __builtin_amdgcn_mfma_f32_32x32x16_bf16(b0, qr[d0], p0, 0, 0, 0); p1 = __builtin_amdgcn_mfma_f32_32x32x16_bf16(b1, qr[d0], p1, 0, 0, 0); } }
}
typedef __attribute__((address_space(3))) const char* lds_cptr;
typedef __attribute__((address_space(3))) const float* lds_fptr;
typedef short v4i16_t __attribute__((ext_vector_type(4)));
__device__ __forceinline__ void kload8(bf16x8* kf, lds_cptr kp) {
  kf[0] = *(const __attribute__((address_space(3))) bf16x8*)(kp);        kf[1] = *(const __attribute__((address_space(3))) bf16x8*)(kp + 512);
  kf[2] = *(const __attribute__((address_space(3))) bf16x8*)(kp + 2048); kf[3] = *(const __attribute__((address_space(3))) bf16x8*)(kp + 2560);
  kf[4] = *(const __attribute__((address_space(3))) bf16x8*)(kp + 4096); kf[5] = *(const __attribute__((address_space(3))) bf16x8*)(kp + 4608);
  kf[6] = *(const __attribute__((address_space(3))) bf16x8*)(kp + 6144); kf[7] = *(const __attribute__((address_space(3))) bf16x8*)(kp + 6656);
}
__device__ __forceinline__ void kload2(bf16x8* kf, lds_cptr kp, int j) { kf[2 * j] = *(const __attribute__((address_space(3))) bf16x8*)(kp + j * 2048); kf[2 * j + 1] = *(const __attribute__((address_space(3))) bf16x8*)(kp + j * 2048 + 512); }
__device__ __forceinline__ s16x4 vtr(lds_cptr p) { return __builtin_bit_cast(s16x4, __builtin_amdgcn_ds_read_tr16_b64_v4i16((__attribute__((address_space(3))) v4i16_t*)p)); }
__device__ __forceinline__ float rowmax(const f32x16& p0, const f32x16& p1) {
  float a = max3f(p0[0], p0[1], p1[0]), b = max3f(p0[2], p0[3], p1[1]); a = max3f(a, p1[2], p1[3]);
  #pragma unroll
  for (int r = 4; r < 16; r += 4) { a = max3f(a, p0[r], p0[r + 1]); b = max3f(b, p0[r + 2], p0[r + 3]); a = max3f(a, p1[r], p1[r + 1]); b = max3f(b, p1[r + 2], p1[r + 3]); }
  const float m = max2f(a, b);
  auto rr = __builtin_amdgcn_permlane32_swap(__float_as_uint(m), __float_as_uint(m), false, false);
  return max2f(__uint_as_float(rr[0]), __uint_as_float(rr[1]));
}
__device__ __forceinline__ void pv(f32x16* o, int vb, bf16x8 pa0, bf16x8 pa1, bf16x8 pa2, bf16x8 pa3) {
  #pragma unroll
  for (int d0 = 0; d0 < 2; ++d0) { s16x4 lo[4], hi[4];
    #pragma unroll
    for (int ks = 0; ks < 4; ++ks) {
      asm volatile("ds_read_b64_tr_b16 %0,%1 offset:%c2" : "=&v"(lo[ks]) : "v"(vb), "i"(d0 * 4096 + ks * 1024) : "memory");
      asm volatile("ds_read_b64_tr_b16 %0,%1 offset:%c2" : "=&v"(hi[ks]) : "v"(vb), "i"(d0 * 4096 + ks * 1024 + 512) : "memory"); }
    asm volatile("s_waitcnt lgkmcnt(0)" ::: "memory"); SBAR();
    #define PK(k) (bf16x8){lo[k][0], lo[k][1], lo[k][2], lo[k][3], hi[k][0], hi[k][1], hi[k][2], hi[k][3]}
    o[d0] = __builtin_amdgcn_mfma_f32_32x32x16_bf16(pa0, PK(0), o[d0], 0, 0, 0);
    o[d0] = __builtin_amdgcn_mfma_f32_32x32x16_bf16(pa1, PK(1), o[d0], 0, 0, 0);
    o[d0] = __builtin_amdgcn_mfma_f32_32x32x16_bf16(pa2, PK(2), o[d0], 0, 0, 0);
    o[d0] = __builtin_amdgcn_mfma_f32_32x32x16_bf16(pa3, PK(3), o[d0], 0, 0, 0);
    #undef PK
  }
}
template <int GSZ> __device__ __forceinline__ void addbias(f32x16& p0, f32x16& p1, lds_fptr tab, int dq) {
  const lds_fptr tp = tab + (dq + 256 - 64);
  asm volatile("s_waitcnt lgkmcnt(0)" ::: "memory");
  #pragma unroll
  for (int g = 0; g < 16 / GSZ; ++g) {
    float a0[GSZ], a1[GSZ];
    #pragma unroll
    for (int i = 0; i < GSZ; ++i) { const int r = GSZ * g + i, off = (r & 3) + 8 * (r >> 2); a0[i] = tp[64 - off]; a1[i] = tp[32 - off]; }
    asm volatile("s_waitcnt lgkmcnt(0)" ::: "memory");
    #pragma unroll
    for (int i = 0; i < GSZ; ++i) { const int r = GSZ * g + i; p0[r] = fadd_s(p0[r], a0[i]); p1[r] = fadd_s(p1[r], a1[i]); }
    SBAR(); }
}

__device__ __forceinline__ void addbias_far(f32x16& p0, f32x16& p1, float subc) {
  #pragma unroll
  for (int r = 0; r < 16; ++r) { p0[r] = fsub_s(p0[r], subc); p1[r] = fsub_s(p1[r], subc); }
}
#define ATTN_STORE16(p, v) (*(u32x4*)(p) = (v))
template<int MODE, int THRL, int OP> __device__ __forceinline__ void attn_unit(int b, int qb, const bf16* Q, int qc, const bf16* __restrict__ K, int kc, const bf16* __restrict__ V, int vc,
                                                                      bf16* O, int oc, const bf16* KM, char* shm, const int wid) {
  constexpr int qp = 1024, kp = 1024, vp = 1024, op = OP, kmp = 1024;
  const int lane = lane_now(), r32 = lane & 31, hi = lane >> 5;
  const long rowbase = (long)b * SEQ; const int q0 = qb * QB;
  const bf16* Qw = Q + (rowbase + q0 + wid * QBLK) * qp + qc;
  const bf16* Kh = K + rowbase * kp + kc, *Vh = V + rowbase * vp + vc;
  const unsigned lds0 = (unsigned)(uintptr_t)shm;
  float* wsf = (float*)(shm + LDS_WS) + wid * 64;
  const lds_fptr tab = (lds_fptr)(lds_cptr)shm + LDS_TAB / 4;
  const unsigned koff = (unsigned)(lane * kp + wid * 8) * 2u;
  const unsigned voff = (unsigned)((16 * (wid & 3) + (lane >> 2)) * vp + (wid >> 2) * 32 + (lane & 3) * 8) * 2u;
  const unsigned kdst = lds0 + LDS_K + wid * 1024, vdst = lds0 + LDS_V + wid * 1024;
  #define DMA_K(t, slot) glds16s(Kh + (long)(t) * KVBLK * kp, koff, (unsigned)__builtin_amdgcn_readfirstlane(kdst + (slot)))
  #define DMA_V(t, slot) glds16s(Vh + (long)(t) * KVBLK * vp, voff, (unsigned)__builtin_amdgcn_readfirstlane(vdst + (slot)))
  const int vb0 = (int)(lds0 + LDS_V) + ((lane >> 4) & 1) * 32 + (lane & 3) * 8 + (4 * hi + ((lane & 15) >> 2)) * 64;
  const char* Kbase = shm + LDS_K; bf16x8 kf[8];
  const lds_cptr shm3 = (lds_cptr)shm; const lds_cptr kp0 = shm3 + LDS_K + hi * 1024 + r32 * 16; const lds_cptr vp0 = shm3 + LDS_V + ((lane >> 4) & 1) * 32 + (lane & 3) * 8 + (4 * hi + ((lane & 15) >> 2)) * 64;
  const int NT = (q0 + QB) / KVBLK;
  bf16x8 qr[4];
  #pragma unroll
  for (int d0 = 0; d0 < 4; ++d0) qr[d0] = *reinterpret_cast<const bf16x8*>(&Qw[(long)r32 * qp + d0 * 16 + hi * 8]);
  unsigned selmask = 0xffffffffu;
  if constexpr (MODE == 1) {
    glds16s(KM, (unsigned)(lane * kmp + wid * 8) * 2u, (unsigned)__builtin_amdgcn_readfirstlane(kdst));
    WAIT_BAR(0);
    f32x16 g0, g1; { const f32x16 z = f32x16{}; qkt(g0, g1, Kbase, qr, z, r32, hi); }
    asm volatile("s_nop 15\n\ts_nop 7" : "+v"(g0), "+v"(g1));
    float gg[16];
    #pragma unroll
    for (int r = 0; r < 8; ++r) { const float own = g0[r], oth = __shfl_xor(own, 32); const float lo = hi ? oth : own, hh = hi ? own : oth;
      gg[(r & 3) + 8 * (r >> 2)] = lo; gg[4 + (r & 3) + 8 * (r >> 2)] = hh; }
    #pragma unroll
    for (int n = 0; n < 16; ++n) gg[n] = (n < qb) ? gg[n] : -INFINITY;
    selmask = 0u;
    #pragma unroll
    for (int n = 0; n < 16; ++n) { int cnt = 0;
      #pragma unroll
      for (int m2 = 0; m2 < 16; ++m2) { if (m2 == n) continue; cnt += (gg[m2] > gg[n] || (gg[m2] == gg[n] && m2 < n)) ? 1 : 0; }
      const unsigned bit = (n < qb && cnt < 3) ? 1u : 0u; selmask |= bit << n; }
    asm volatile("s_waitcnt lgkmcnt(0)\n\ts_barrier" ::: "memory");
  }
  DMA_K(0, 0); DMA_V(0, 0); DMA_K(1, SLOTB);
  float mhat = 0.f, l_reg = 0.f; f32x16 o[2]; o[0] = f32x16{}; o[1] = f32x16{}; f32x16 negm = f32x16{}; asm volatile("" : "+v"(negm));
  const int qrel = wid * QBLK + r32;
  const int dq0 = q0 + qrel - 4 * hi;
  #define CMASK(P0, P1, t) do { int jb_ = (t) - (NT - 4); if (jb_ >= 0) cmask(P0, P1, jb_, qrel, hi); } while (0)
  #define BIAS(P0, P1, t) do { \
      if (MODE == 1) { if ((t) < NT - 4) { if (!((selmask >> ((t) >> 2)) & 1u)) { _Pragma("unroll") for (int r = 0; r < 16; ++r) { P0[r] = fsub_s(P0[r], 4096.f); P1[r] = fsub_s(P1[r], 4096.f); } } } } \
      if (64 * (t) + 853 > q0 + wid * QBLK) addbias<8>(P0, P1, tab, dq0 - 64 * (t)); } while (0)
  bool resc = false;
  #define START(P0, P1) do { const float rm = rowmax(P0, P1); resc = false; \
    { const float dl = rm; mhat = fadd_s(mhat, dl); \
      _Pragma("unroll") for (int r = 0; r < 16; ++r) { P0[r] = fsub_s(P0[r], dl); P1[r] = fsub_s(P1[r], dl); } \
      _Pragma("unroll") for (int r = 0; r < 16; ++r) negm[r] = -mhat; asm volatile("" : "+v"(negm)); } \
    _Pragma("unroll") for (int r = 0; r < 16; ++r) P0[r] = __builtin_amdgcn_exp2f(P0[r]); } while (0)
  #define RESC() do { if (resc) { asm volatile("s_waitcnt lgkmcnt(0)" ::: "memory"); \
      _Pragma("unroll") for (int d_ = 0; d_ < 2; ++d_) _Pragma("unroll") for (int r = 0; r < 16; ++r) o[d_][r] *= wsf[crow(r, hi)]; } } while (0)
  f32x16 pA0, pA1, pB0, pB1;
  int sl_prev = 0, sl_cur = 0, sl_next = SLOTB;
  #define ROT() do { sl_prev = sl_cur; sl_cur = sl_next; sl_next = (sl_next == (NSLOT - 1) * SLOTB) ? 0 : sl_next + SLOTB; } while (0)
  DMA_K(2, 2 * SLOTB);
  WAIT_BAR(3);
  qkt(pA0, pA1, Kbase, qr, negm, r32, hi); asm volatile("s_nop 15\n\ts_nop 7" : "+v"(pA0), "+v"(pA1)); BIAS(pA0, pA1, 0); CMASK(pA0, pA1, 0);
  START(pA0, pA1);
  _Pragma("unroll") for (int r = 0; r < 16; ++r) pA1[r] = __builtin_amdgcn_exp2f(pA1[r]);
  WAIT_BAR(0);
  DMA_K(3, 0); DMA_V(1, SLOTB);
  ROT();
  kload8(kf, kp0 + sl_cur);
  WAIT_BAR(2);
  s16x4 vlo[8], vhi[8]; u32x4 pw0, pw1, pw2, pw3;
  #define PKW(P, B) cvtpk_s(P[B], P[B + 1])
  #define PAF(k) __builtin_bit_cast(bf16x8, pw##k)
  #define VFR(i) (bf16x8){vlo[i][0], vlo[i][1], vlo[i][2], vlo[i][3], vhi[i][0], vhi[i][1], vhi[i][2], vhi[i][3]}
  #define PIN(x) asm volatile("" : "+v"(x))
  #define MX3(a, b, c) __builtin_fmaxf(__builtin_fmaxf((a), (b)), (c))
  #define GAPA(MF, A0, A1, A2, A3, W0, W1, PW) do { MF; sacc += A0; sacc += A1; sacc += A2; sacc += A3; PIN(sacc); W0; W1; PIN(PW); SBAR(); } while (0)
  #define EX(v) __builtin_amdgcn_exp2f(v)
  #define GAPB(MF, X, B) do { MF; X[B] = EX(X[B]); X[B + 1] = EX(X[B + 1]); X[B + 2] = EX(X[B + 2]); X[B + 3] = EX(X[B + 3]); PIN(X); SBAR(); } while (0)
  #define VRD(i) do { vlo[i] = vtr(vp_ + (((i) >> 2) * 4096 + ((i) & 3) * 1024)); vhi[i] = vtr(vp_ + (((i) >> 2) * 4096 + ((i) & 3) * 1024 + 512)); } while (0)
  #define KRD(G, j) do { if (G) { kload2(kf, kp0 + sl_next, j); SBAR(); } } while (0)
  #define STEP(C0, C1, P0, P1, t, GK, GV, GL) do { SBAR(); \
    const lds_cptr vp_ = vp0 + sl_prev; \
    VRD(0); SBAR(); float sacc = (P0[0] + P0[1]); \
    GAPA(C0 = __builtin_amdgcn_mfma_f32_32x32x16_bf16(kf[0], qr[0], negm, 0, 0, 0), P0[2], P0[3], P0[4], P0[5],     pw0[0] = PKW(P0, 0), pw0[1] = PKW(P0, 2), pw0); \
    VRD(4); SBAR(); GAPA(C1 = __builtin_amdgcn_mfma_f32_32x32x16_bf16(kf[1], qr[0], negm, 0, 0, 0), P0[6], P0[7], P0[8], P0[9],     pw0[2] = PKW(P0, 4), pw0[3] = PKW(P0, 6), pw0); \
    VRD(1); SBAR(); GAPA(C0 = __builtin_amdgcn_mfma_f32_32x32x16_bf16(kf[2], qr[1], C0, 0, 0, 0),   P0[10], P0[11], P0[12], P0[13], pw1[0] = PKW(P0, 8), pw1[1] = PKW(P0, 10), pw1); \
    VRD(5); SBAR(); GAPA(C1 = __builtin_amdgcn_mfma_f32_32x32x16_bf16(kf[3], qr[1], C1, 0, 0, 0),   P0[14], P0[15], P1[0], P1[1],   pw1[2] = PKW(P0, 12), pw1[3] = PKW(P0, 14), pw1); \
    VRD(2); SBAR(); GAPA(C0 = __builtin_amdgcn_mfma_f32_32x32x16_bf16(kf[4], qr[2], C0, 0, 0, 0),   P1[2], P1[3], P1[4], P1[5],     pw2[0] = PKW(P1, 0), pw2[1] = PKW(P1, 2), pw2); \
    VRD(6); SBAR(); GAPA(C1 = __builtin_amdgcn_mfma_f32_32x32x16_bf16(kf[5], qr[2], C1, 0, 0, 0),   P1[6], P1[7], P1[8], P1[9],     pw2[2] = PKW(P1, 4), pw2[3] = PKW(P1, 6), pw2); \
    VRD(3); SBAR(); GAPA(C0 = __builtin_amdgcn_mfma_f32_32x32x16_bf16(kf[6], qr[3], C0, 0, 0, 0),   P1[10], P1[11], P1[12], P1[13], pw3[0] = PKW(P1, 8), pw3[1] = PKW(P1, 10), pw3); \
    VRD(7); SBAR(); GAPA(C1 = __builtin_amdgcn_mfma_f32_32x32x16_bf16(kf[7], qr[3], C1, 0, 0, 0),   P1[14], P1[15], 0.f, 0.f,       pw3[2] = PKW(P1, 12), pw3[3] = PKW(P1, 14), pw3); \
    l_reg += sacc; \
    if (GK) { DMA_K((t) + 3, sl_cur); } if (GV) { DMA_V((t) + 1, sl_next); } \
    asm volatile("s_nop 15\n\ts_nop 3" : "+v"(C0), "+v"(C1)); BIAS(C0, C1, t); \
    CMASK(C0, C1, t); \
    { float a = MX3(C0[0], C0[1], C1[0]), b = MX3(C0[2], C0[3], C1[1]); a = MX3(a, C1[2], C1[3]); \
      _Pragma("unroll") for (int r = 4; r < 16; r += 4) { a = MX3(a, C0[r], C0[r + 1]); b = MX3(b, C0[r + 2], C0[r + 3]); a = MX3(a, C1[r], C1[r + 1]); b = MX3(b, C1[r + 2], C1[r + 3]); } \
      float rm = __builtin_fmaxf(a, b); { auto rr = __builtin_amdgcn_permlane32_swap(__float_as_uint(rm), __float_as_uint(rm), false, false); rm = __builtin_fmaxf(__uint_as_float(rr[0]), __uint_as_float(rr[1])); } \
      resc = false; \
      if (__builtin_expect(__any(rm > (float)THRL), 0)) { const float dl = __builtin_fmaxf(rm, 0.f); mhat += dl; \
        _Pragma("unroll") for (int r = 0; r < 16; ++r) { C0[r] -= dl; C1[r] -= dl; } \
        _Pragma("unroll") for (int r = 0; r < 16; ++r) negm[r] = -mhat; asm volatile("" : "+v"(negm)); \
        const float f = __builtin_amdgcn_exp2f(-dl); l_reg *= f; if (hi == 0) wsf[r32] = f; resc = true; } } \
    SBAR(); \
    GAPB(o[0] = __builtin_amdgcn_mfma_f32_32x32x16_bf16(PAF(0), VFR(0), o[0], 0, 0, 0), C0, 0); \
    GAPB(o[1] = __builtin_amdgcn_mfma_f32_32x32x16_bf16(PAF(0), VFR(4), o[1], 0, 0, 0), C0, 4); \
    KRD(GL, 0); GAPB(o[0] = __builtin_amdgcn_mfma_f32_32x32x16_bf16(PAF(1), VFR(1), o[0], 0, 0, 0), C0, 8); \
    KRD(GL, 1); GAPB(o[1] = __builtin_amdgcn_mfma_f32_32x32x16_bf16(PAF(1), VFR(5), o[1], 0, 0, 0), C0, 12); \
    KRD(GL, 2); GAPB(o[0] = __builtin_amdgcn_mfma_f32_32x32x16_bf16(PAF(2), VFR(2), o[0], 0, 0, 0), C1, 0); \
    KRD(GL, 3); GAPB(o[1] = __builtin_amdgcn_mfma_f32_32x32x16_bf16(PAF(2), VFR(6), o[1], 0, 0, 0), C1, 4); \
    GAPB(o[0] = __builtin_amdgcn_mfma_f32_32x32x16_bf16(PAF(3), VFR(3), o[0], 0, 0, 0), C1, 8); \
    GAPB(o[1] = __builtin_amdgcn_mfma_f32_32x32x16_bf16(PAF(3), VFR(7), o[1], 0, 0, 0), C1, 12); \
    } while (0)
  int t = 1;
  #undef CMASK
  #define CMASK(P0, P1, t) do {} while (0)
  for (; t + 5 < NT; t += 2) {
    STEP(pB0, pB1, pA0, pA1, t, true, true, true);     WAIT_BAR(2); RESC(); ROT();
    STEP(pA0, pA1, pB0, pB1, t + 1, true, true, true); WAIT_BAR(2); RESC(); ROT();
  }
  #undef CMASK
  #define CMASK(P0, P1, t) do { int jb_ = (t) - (NT - 4); if (jb_ >= 0) cmask(P0, P1, jb_, qrel, hi); } while (0)
  #define ENDW(tt) do { if ((tt) + 3 < NT) { WAIT_BAR(2); } else if ((tt) + 2 < NT) { WAIT_BAR(1); } else { WAIT_BAR(0); } } while (0)
  for (; t + 1 < NT; t += 2) {
    STEP(pB0, pB1, pA0, pA1, t, (t + 3 < NT), (t + 1 < NT), (t + 1 < NT));     ENDW(t);     RESC(); ROT();
    STEP(pA0, pA1, pB0, pB1, t + 1, (t + 4 < NT), (t + 2 < NT), (t + 2 < NT)); ENDW(t + 1); RESC(); ROT();
  }
  STEP(pB0, pB1, pA0, pA1, NT - 1, false, false, false); RESC();
  { float sacc = pB0[0] + pB0[1]; _Pragma("unroll") for (int r = 2; r < 16; ++r) sacc += pB0[r]; _Pragma("unroll") for (int r = 0; r < 16; ++r) sacc += pB1[r]; l_reg += sacc;
    pw0 = (u32x4){PKW(pB0, 0), PKW(pB0, 2), PKW(pB0, 4), PKW(pB0, 6)}; pw1 = (u32x4){PKW(pB0, 8), PKW(pB0, 10), PKW(pB0, 12), PKW(pB0, 14)}; pw2 = (u32x4){PKW(pB1, 0), PKW(pB1, 2), PKW(pB1, 4), PKW(pB1, 6)}; pw3 = (u32x4){PKW(pB1, 8), PKW(pB1, 10), PKW(pB1, 12), PKW(pB1, 14)};
    SBAR(); pv(o, vb0 + sl_cur, PAF(0), PAF(1), PAF(2), PAF(3)); }
  #undef PKW
  #undef PAF
  #undef VFR
  #undef PIN
  #undef MX3
  #undef GAPA
  #undef GAPB
  #undef EX
  #undef VRD
  #undef KRD
  #undef STEP
  #undef ENDW
  { auto rr = __builtin_amdgcn_permlane32_swap(__float_as_uint(l_reg), __float_as_uint(l_reg), false, false); l_reg = __uint_as_float(rr[0]) + __uint_as_float(rr[1]); }
  if (hi == 0) wsf[32 + r32] = l_reg; asm volatile("s_waitcnt lgkmcnt(0)" ::: "memory");
  float rli[16];
  #pragma unroll
  for (int r = 0; r < 16; ++r) rli[r] = __builtin_amdgcn_rcpf(wsf[32 + crow(r, hi)]);
  bf16* Ow = O + (rowbase + q0 + wid * QBLK) * op + oc;
  { bf16* stg = (bf16*)(shm + LDS_OST) + wid * 2048;
    #pragma unroll
    for (int r = 0; r < 16; ++r) { const int orow = crow(r, hi);
      #pragma unroll
      for (int d0 = 0; d0 < 2; ++d0) stg[orow * 64 + d0 * 32 + r32] = __float2bfloat16(o[d0][r] * rli[r]); }
    asm volatile("s_waitcnt lgkmcnt(0)" ::: "memory");
    #pragma unroll
    for (int i = 0; i < 4; ++i) { const int row = i * 8 + (lane >> 3), ch = lane & 7; const u32x4 v = *(const u32x4*)(stg + row * 64 + ch * 8); ATTN_STORE16(Ow + (long)row * op + ch * 8, v); } }
  asm volatile("s_waitcnt lgkmcnt(0)\n\ts_barrier" ::: "memory");
  #undef DMA_K
  #undef DMA_V
  #undef CMASK
  #undef BIAS
  #undef START
  #undef RESC
  #undef ROT
}
constexpr int V2_K = 0, V2_V = 24576, V2_WS = 73728, V2_Q = 75776, V2_TAB = 110592;
template<int THRL> __device__ __forceinline__ void attn_unit_v128(int b, int qb, const bf16* Q, int qc, const bf16* __restrict__ K, int kc, const bf16* __restrict__ V, int vc,
                                                                 bf16* O, int oc, char* shm, const int wid) {
  constexpr int MODE = 0; constexpr int qp = 1024, kp = 1024, vp = 1024, op = 2048;
  const int lane = lane_now(), r32 = lane & 31, hi = lane >> 5;
  const long rowbase = (long)b * SEQ; const int q0 = qb * QB;
  const bf16* Qw = Q + (rowbase + q0 + wid * QBLK) * qp + qc;
  const bf16* Kh = K + rowbase * kp + kc, *Vh = V + rowbase * vp + vc;
  const unsigned lds0 = (unsigned)(uintptr_t)shm;
  float* wsf = (float*)(shm + V2_WS) + wid * 64;
  const lds_fptr tab = (lds_fptr)(lds_cptr)shm + V2_TAB / 4;
  const unsigned koff = (unsigned)(lane * kp + wid * 8) * 2u;
  const unsigned voff = (unsigned)((16 * (wid & 3) + (lane >> 2)) * vp + (wid >> 2) * 32 + (lane & 3) * 8) * 2u;
  const unsigned kdst = lds0 + V2_K + wid * 1024, vdst = lds0 + V2_V + wid * 1024;
  #define DMA_K(t, slot) glds16s(Kh + (long)(t) * KVBLK * kp, koff, (unsigned)__builtin_amdgcn_readfirstlane(kdst + (slot)))
  #define DMA_V(t, slot) do { glds16s(Vh + (long)(t) * KVBLK * vp, voff, (unsigned)__builtin_amdgcn_readfirstlane(vdst + 2 * (slot))); glds16s(Vh + (long)(t) * KVBLK * vp, voff + 128u, (unsigned)__builtin_amdgcn_readfirstlane(vdst + 2 * (slot) + 8192)); } while (0)
  const int vb0 = (int)(lds0 + V2_V) + ((lane >> 4) & 1) * 32 + (lane & 3) * 8 + (4 * hi + ((lane & 15) >> 2)) * 64;
  const char* Kbase = shm + V2_K; bf16x8 kf[8];
  const lds_cptr shm3 = (lds_cptr)shm; const lds_cptr kp0 = shm3 + V2_K + hi * 1024 + r32 * 16; const lds_cptr vp0 = shm3 + V2_V + ((lane >> 4) & 1) * 32 + (lane & 3) * 8 + (4 * hi + ((lane & 15) >> 2)) * 64;
  const int NT = (q0 + QB) / KVBLK;
  bf16x8 qr[4];
  #pragma unroll
  for (int d0 = 0; d0 < 4; ++d0) qr[d0] = *reinterpret_cast<const bf16x8*>(&Qw[(long)r32 * qp + d0 * 16 + hi * 8]);
  typedef __attribute__((address_space(3))) bf16x8* lds_qptr; const lds_qptr qlds = (lds_qptr)(shm3 + V2_Q + wid * 4096 + lane * 16);
  DMA_K(0, 0); DMA_V(0, 0); DMA_K(1, SLOTB);
  float mhat = 0.f, l_reg = 0.f; f32x16 o[4]; o[0] = f32x16{}; o[1] = f32x16{}; o[2] = f32x16{}; o[3] = f32x16{}; const f32x16 negm = f32x16{};
  const int qrel = wid * QBLK + r32;
  const int dq0 = q0 + qrel - 4 * hi;
  #define CMASK(P0, P1, t) do { int jb_ = (t) - (NT - 4); if (jb_ >= 0) cmask(P0, P1, jb_, qrel, hi); } while (0)
  #define BIAS(P0, P1, t) do { if (64 * (t) + 853 > q0 + wid * QBLK) addbias<8>(P0, P1, tab, dq0 - 64 * (t)); addbias_far(P0, P1, mhat); } while (0)
  bool resc = false;
  #define START(P0, P1) do { const float rm = rowmax(P0, P1); resc = false; \
    { const float dl = rm; mhat = fadd_s(mhat, dl); \
      _Pragma("unroll") for (int r = 0; r < 16; ++r) { P0[r] = fsub_s(P0[r], dl); P1[r] = fsub_s(P1[r], dl); } \
      } \
    _Pragma("unroll") for (int r = 0; r < 16; ++r) P0[r] = __builtin_amdgcn_exp2f(P0[r]); } while (0)
  #define RESC() do { if (resc) { asm volatile("s_waitcnt lgkmcnt(0)" ::: "memory"); \
      _Pragma("unroll") for (int d_ = 0; d_ < 4; ++d_) _Pragma("unroll") for (int r = 0; r < 16; ++r) o[d_][r] *= wsf[crow(r, hi)]; } } while (0)
  f32x16 pA0, pA1, pB0, pB1;
  int sl_prev = 0, sl_cur = 0, sl_next = SLOTB;
  #define ROT() do { sl_prev = sl_cur; sl_cur = sl_next; sl_next = (sl_next == (NSLOT - 1) * SLOTB) ? 0 : sl_next + SLOTB; } while (0)
  DMA_K(2, 2 * SLOTB);
  WAIT_BAR(4);
  qkt(pA0, pA1, Kbase, qr, negm, r32, hi); asm volatile("s_nop 15\n\ts_nop 7" : "+v"(pA0), "+v"(pA1)); BIAS(pA0, pA1, 0); CMASK(pA0, pA1, 0);
  START(pA0, pA1);
  _Pragma("unroll") for (int r = 0; r < 16; ++r) pA1[r] = __builtin_amdgcn_exp2f(pA1[r]);
  _Pragma("unroll") for (int d0 = 0; d0 < 4; ++d0) qlds[64 * d0] = qr[d0];
  WAIT_BAR(0);
  DMA_K(3, 0); DMA_V(1, SLOTB);
  ROT();
  kload8(kf, kp0 + sl_cur);
  WAIT_BAR(3);
  s16x4 vlo[8], vhi[8]; u32x4 pw0, pw1, pw2, pw3;
  #define PKW(P, B) cvtpk_s(P[B], P[B + 1])
  #define PAF(k) __builtin_bit_cast(bf16x8, pw##k)
  #define VFR(i) (bf16x8){vlo[i][0], vlo[i][1], vlo[i][2], vlo[i][3], vhi[i][0], vhi[i][1], vhi[i][2], vhi[i][3]}
  #define PIN(x) asm volatile("" : "+v"(x))
  #define MX3(a, b, c) __builtin_fmaxf(__builtin_fmaxf((a), (b)), (c))
  #define GAPA(MF, A0, A1, A2, A3, W0, W1, PW) do { MF; sacc += A0; sacc += A1; sacc += A2; sacc += A3; PIN(sacc); W0; W1; PIN(PW); SBAR(); } while (0)
  #define EX(v) __builtin_amdgcn_exp2f(v)
  #define GAPB(MF, X, B) do { MF; X[B] = EX(X[B]); X[B + 1] = EX(X[B + 1]); X[B + 2] = EX(X[B + 2]); X[B + 3] = EX(X[B + 3]); PIN(X); SBAR(); } while (0)
  #define VRD(i) do { vlo[i] = vtr(vp_ + (((i) >> 2) * 4096 + ((i) & 3) * 1024)); vhi[i] = vtr(vp_ + (((i) >> 2) * 4096 + ((i) & 3) * 1024 + 512)); } while (0)
  #define VRD2(i) do { vlo[i] = vtr(vp_ + (8192 + ((i) >> 2) * 4096 + ((i) & 3) * 1024)); vhi[i] = vtr(vp_ + (8192 + ((i) >> 2) * 4096 + ((i) & 3) * 1024 + 512)); SBAR(); } while (0)
  #define GAPB2(MF, X, B) do { MF; X[B] = EX(X[B]); X[B + 1] = EX(X[B + 1]); PIN(X); SBAR(); } while (0)
  #define KRD(G, j) do { if (G) { kload2(kf, kp0 + sl_next, j); SBAR(); } } while (0)
  #define STEP(C0, C1, P0, P1, t, GK, GV, GL) do { SBAR(); \
    const lds_cptr vp_ = vp0 + 2 * sl_prev; \
    const bf16x8 qf0 = qlds[0], qf1 = qlds[64], qf2 = qlds[128], qf3 = qlds[192]; \
    VRD(0); SBAR(); float sacc = (P0[0] + P0[1]); \
    GAPA(C0 = __builtin_amdgcn_mfma_f32_32x32x16_bf16(kf[0], qf0, negm, 0, 0, 0), P0[2], P0[3], P0[4], P0[5],     pw0[0] = PKW(P0, 0), pw0[1] = PKW(P0, 2), pw0); \
    VRD(4); SBAR(); GAPA(C1 = __builtin_amdgcn_mfma_f32_32x32x16_bf16(kf[1], qf0, negm, 0, 0, 0), P0[6], P0[7], P0[8], P0[9],     pw0[2] = PKW(P0, 4), pw0[3] = PKW(P0, 6), pw0); \
    VRD(1); SBAR(); GAPA(C0 = __builtin_amdgcn_mfma_f32_32x32x16_bf16(kf[2], qf1, C0, 0, 0, 0),   P0[10], P0[11], P0[12], P0[13], pw1[0] = PKW(P0, 8), pw1[1] = PKW(P0, 10), pw1); \
    VRD(5); SBAR(); GAPA(C1 = __builtin_amdgcn_mfma_f32_32x32x16_bf16(kf[3], qf1, C1, 0, 0, 0),   P0[14], P0[15], P1[0], P1[1],   pw1[2] = PKW(P0, 12), pw1[3] = PKW(P0, 14), pw1); \
    VRD(2); SBAR(); GAPA(C0 = __builtin_amdgcn_mfma_f32_32x32x16_bf16(kf[4], qf2, C0, 0, 0, 0),   P1[2], P1[3], P1[4], P1[5],     pw2[0] = PKW(P1, 0), pw2[1] = PKW(P1, 2), pw2); \
    VRD(6); SBAR(); GAPA(C1 = __builtin_amdgcn_mfma_f32_32x32x16_bf16(kf[5], qf2, C1, 0, 0, 0),   P1[6], P1[7], P1[8], P1[9],     pw2[2] = PKW(P1, 4), pw2[3] = PKW(P1, 6), pw2); \
    VRD(3); SBAR(); GAPA(C0 = __builtin_amdgcn_mfma_f32_32x32x16_bf16(kf[6], qf3, C0, 0, 0, 0),   P1[10], P1[11], P1[12], P1[13], pw3[0] = PKW(P1, 8), pw3[1] = PKW(P1, 10), pw3); \
    VRD(7); SBAR(); GAPA(C1 = __builtin_amdgcn_mfma_f32_32x32x16_bf16(kf[7], qf3, C1, 0, 0, 0),   P1[14], P1[15], 0.f, 0.f,       pw3[2] = PKW(P1, 12), pw3[3] = PKW(P1, 14), pw3); \
    l_reg += sacc; \
    if (GK) { DMA_K((t) + 3, sl_cur); } if (GV) { DMA_V((t) + 1, sl_next); } \
    asm volatile("s_nop 15\n\ts_nop 3" : "+v"(C0), "+v"(C1)); BIAS(C0, C1, t); \
    CMASK(C0, C1, t); \
    { float a = MX3(C0[0], C0[1], C1[0]), b = MX3(C0[2], C0[3], C1[1]); a = MX3(a, C1[2], C1[3]); \
      _Pragma("unroll") for (int r = 4; r < 16; r += 4) { a = MX3(a, C0[r], C0[r + 1]); b = MX3(b, C0[r + 2], C0[r + 3]); a = MX3(a, C1[r], C1[r + 1]); b = MX3(b, C1[r + 2], C1[r + 3]); } \
      float rm = __builtin_fmaxf(a, b); { auto rr = __builtin_amdgcn_permlane32_swap(__float_as_uint(rm), __float_as_uint(rm), false, false); rm = __builtin_fmaxf(__uint_as_float(rr[0]), __uint_as_float(rr[1])); } \
      resc = false; \
      if (__builtin_expect(__any(rm > (float)THRL), 0)) { const float dl = __builtin_fmaxf(rm, 0.f); mhat += dl; \
        _Pragma("unroll") for (int r = 0; r < 16; ++r) { C0[r] -= dl; C1[r] -= dl; } \
        const float f = __builtin_amdgcn_exp2f(-dl); l_reg *= f; if (hi == 0) wsf[r32] = f; resc = true; } } \
    SBAR(); \
    GAPB2(o[0] = __builtin_amdgcn_mfma_f32_32x32x16_bf16(PAF(0), VFR(0), o[0], 0, 0, 0), C0, 0); VRD2(0); \
    GAPB2(o[1] = __builtin_amdgcn_mfma_f32_32x32x16_bf16(PAF(0), VFR(4), o[1], 0, 0, 0), C0, 2); VRD2(4); \
    GAPB2(o[0] = __builtin_amdgcn_mfma_f32_32x32x16_bf16(PAF(1), VFR(1), o[0], 0, 0, 0), C0, 4); VRD2(1); \
    GAPB2(o[1] = __builtin_amdgcn_mfma_f32_32x32x16_bf16(PAF(1), VFR(5), o[1], 0, 0, 0), C0, 6); VRD2(5); \
    GAPB2(o[0] = __builtin_amdgcn_mfma_f32_32x32x16_bf16(PAF(2), VFR(2), o[0], 0, 0, 0), C0, 8); VRD2(2); \
    GAPB2(o[1] = __builtin_amdgcn_mfma_f32_32x32x16_bf16(PAF(2), VFR(6), o[1], 0, 0, 0), C0, 10); VRD2(6); \
    GAPB2(o[0] = __builtin_amdgcn_mfma_f32_32x32x16_bf16(PAF(3), VFR(3), o[0], 0, 0, 0), C0, 12); VRD2(3); \
    GAPB2(o[1] = __builtin_amdgcn_mfma_f32_32x32x16_bf16(PAF(3), VFR(7), o[1], 0, 0, 0), C0, 14); VRD2(7); \
    GAPB2(o[2] = __builtin_amdgcn_mfma_f32_32x32x16_bf16(PAF(0), VFR(0), o[2], 0, 0, 0), C1, 0); \
    GAPB2(o[3] = __builtin_amdgcn_mfma_f32_32x32x16_bf16(PAF(0), VFR(4), o[3], 0, 0, 0), C1, 2); \
    KRD(GL, 0); GAPB2(o[2] = __builtin_amdgcn_mfma_f32_32x32x16_bf16(PAF(1), VFR(1), o[2], 0, 0, 0), C1, 4); \
    KRD(GL, 1); GAPB2(o[3] = __builtin_amdgcn_mfma_f32_32x32x16_bf16(PAF(1), VFR(5), o[3], 0, 0, 0), C1, 6); \
    KRD(GL, 2); GAPB2(o[2] = __builtin_amdgcn_mfma_f32_32x32x16_bf16(PAF(2), VFR(2), o[2], 0, 0, 0), C1, 8); \
    KRD(GL, 3); GAPB2(o[3] = __builtin_amdgcn_mfma_f32_32x32x16_bf16(PAF(2), VFR(6), o[3], 0, 0, 0), C1, 10); \
    GAPB2(o[2] = __builtin_amdgcn_mfma_f32_32x32x16_bf16(PAF(3), VFR(3), o[2], 0, 0, 0), C1, 12); \
    GAPB2(o[3] = __builtin_amdgcn_mfma_f32_32x32x16_bf16(PAF(3), VFR(7), o[3], 0, 0, 0), C1, 14); \
    } while (0)
  int t = 1;
  #undef CMASK
  #define CMASK(P0, P1, t) do {} while (0)
  for (; t + 5 < NT; t += 2) {
    STEP(pB0, pB1, pA0, pA1, t, true, true, true);     WAIT_BAR(3); RESC(); ROT();
    STEP(pA0, pA1, pB0, pB1, t + 1, true, true, true); WAIT_BAR(3); RESC(); ROT();
  }
  #undef CMASK
  #define CMASK(P0, P1, t) do { int jb_ = (t) - (NT - 4); if (jb_ >= 0) cmask(P0, P1, jb_, qrel, hi); } while (0)
  #define ENDW(tt) do { if ((tt) + 3 < NT) { WAIT_BAR(3); } else if ((tt) + 2 < NT) { WAIT_BAR(2); } else { WAIT_BAR(0); } } while (0)
  for (; t + 1 < NT; t += 2) {
    STEP(pB0, pB1, pA0, pA1, t, (t + 3 < NT), (t + 1 < NT), (t + 1 < NT));     ENDW(t);     RESC(); ROT();
    STEP(pA0, pA1, pB0, pB1, t + 1, (t + 4 < NT), (t + 2 < NT), (t + 2 < NT)); ENDW(t + 1); RESC(); ROT();
  }
  STEP(pB0, pB1, pA0, pA1, NT - 1, false, false, false); RESC();
  { float sacc = pB0[0] + pB0[1]; _Pragma("unroll") for (int r = 2; r < 16; ++r) sacc += pB0[r]; _Pragma("unroll") for (int r = 0; r < 16; ++r) sacc += pB1[r]; l_reg += sacc;
    pw0 = (u32x4){PKW(pB0, 0), PKW(pB0, 2), PKW(pB0, 4), PKW(pB0, 6)}; pw1 = (u32x4){PKW(pB0, 8), PKW(pB0, 10), PKW(pB0, 12), PKW(pB0, 14)}; pw2 = (u32x4){PKW(pB1, 0), PKW(pB1, 2), PKW(pB1, 4), PKW(pB1, 6)}; pw3 = (u32x4){PKW(pB1, 8), PKW(pB1, 10), PKW(pB1, 12), PKW(pB1, 14)};
    SBAR(); pv(o, vb0 + 2 * sl_cur, PAF(0), PAF(1), PAF(2), PAF(3)); pv(o + 2, vb0 + 2 * sl_cur + 8192, PAF(0), PAF(1), PAF(2), PAF(3)); }
  #undef PKW
  #undef PAF
  #undef VFR
  #undef PIN
  #undef MX3
  #undef GAPA
  #undef GAPB
  #undef EX
  #undef VRD
  #undef VRD2
  #undef GAPB2
  #undef KRD
  #undef STEP
  #undef ENDW
  { auto rr = __builtin_amdgcn_permlane32_swap(__float_as_uint(l_reg), __float_as_uint(l_reg), false, false); l_reg = __uint_as_float(rr[0]) + __uint_as_float(rr[1]); }
  if (hi == 0) wsf[32 + r32] = l_reg; asm volatile("s_waitcnt lgkmcnt(0)" ::: "memory");
  float rli[16];
  #pragma unroll
  for (int r = 0; r < 16; ++r) rli[r] = __builtin_amdgcn_rcpf(wsf[32 + crow(r, hi)]);
  bf16* Ow = O + (rowbase + q0 + wid * QBLK) * op + oc;
  asm volatile("s_waitcnt lgkmcnt(0)\n\ts_barrier" ::: "memory");
  { bf16* stg = (bf16*)shm + wid * 4096;
    #pragma unroll
    for (int r = 0; r < 16; ++r) { const int orow = crow(r, hi);
      #pragma unroll
      for (int d0 = 0; d0 < 4; ++d0) stg[orow * 128 + d0 * 32 + r32] = __float2bfloat16(o[d0][r] * rli[r]); }
    asm volatile("s_waitcnt lgkmcnt(0)" ::: "memory");
    #pragma unroll
    for (int i = 0; i < 8; ++i) { const int row = i * 4 + (lane >> 4), ch = lane & 15; const u32x4 v = *(const u32x4*)(stg + row * 128 + ch * 8); ATTN_STORE16(Ow + (long)row * op + ch * 8, v); } }
  asm volatile("s_waitcnt lgkmcnt(0)\n\ts_barrier" ::: "memory");
  #undef DMA_K
  #undef DMA_V
  #undef CMASK
  #undef BIAS
  #undef START
  #undef RESC
  #undef ROT
}
#undef SBAR
#undef WAIT_BAR
}

#define XB_TMO      128
#define XB_XCNT(j)  (256  + 64 * (j))
#define XB_XSUB(j)  (1280 + 64 * (j))
#define XB_XGEN(j)  (2304 + 64 * (j))
#define XB_TOP      3328
#define XB_TOPGEN   3392
#define XCD_BAR_WORDS 3456
#define XB_SPIN_CAP (1u << 18)
__device__ __forceinline__ unsigned xb_ld(unsigned* p)              { return __hip_atomic_load(p, __ATOMIC_RELAXED, __HIP_MEMORY_SCOPE_AGENT); }
__device__ __forceinline__ unsigned xb_add(unsigned* p, unsigned v) { return __hip_atomic_fetch_add(p, v, __ATOMIC_RELAXED, __HIP_MEMORY_SCOPE_AGENT); }
__device__ __forceinline__ unsigned xb_xcc_id() { return (unsigned)__builtin_amdgcn_s_getreg((3 << 11) | 20) & 0xFu; }
#define XB_SPIN(cond, bar) do { unsigned _sp = 0; while (cond) { __builtin_amdgcn_s_sleep(1); \
    if ((++_sp & 255u) == 0u) { if (xb_ld(&(bar)[XB_TMO])) break; if (_sp > XB_SPIN_CAP) { atomicAdd(&(bar)[XB_TMO], 1u); break; } } } } while (0)
struct XcdBarrier { unsigned* bar; unsigned x; volatile LAS unsigned* st; };
__device__ __forceinline__ XcdBarrier xcd_barrier_post(unsigned* bar, volatile LAS unsigned* st, const bool t0) {
    XcdBarrier b; b.bar = bar; b.x = xb_xcc_id(); b.st = st;
    if (t0) (void)xb_add(&bar[XB_XCNT(b.x)], 1u);
    return b;
}
__device__ __forceinline__ void xcd_barrier_complete(unsigned* bar, unsigned x, unsigned& nloc, unsigned& nx) {
    const unsigned G = gridDim.x * gridDim.y * gridDim.z;
    unsigned sum, cnt, mine, sp = 0u;
    for (;;) {
        sum = 0u; cnt = 0u; mine = 0u;
#pragma unroll
        for (unsigned j = 0; j < 16; ++j) { const unsigned c = xb_ld(&bar[XB_XCNT(j)]); sum += c; cnt += (c > 0u) ? 1u : 0u; mine = (j == x) ? c : mine; }
        if (sum == G) break;
        __builtin_amdgcn_s_sleep(1);
        if ((++sp & 255u) == 0u) { if (xb_ld(&bar[XB_TMO])) break; if (sp > XB_SPIN_CAP) { atomicAdd(&bar[XB_TMO], 1u); break; } }
    }
    nloc = mine > 0u ? mine : 1u; nx = cnt > 0u ? cnt : 1u;
}
template <int JOB> __device__ __forceinline__ void barrier_job(const struct Ctx& c);
template <int JOB> __device__ __forceinline__ void xcd_barrier(const XcdBarrier& b, const bool t0, const struct Ctx& c) {
    asm volatile("s_waitcnt vmcnt(0)" ::: "memory");
    __syncthreads();
    if (t0) {
        unsigned* bar = b.bar;
        __builtin_amdgcn_s_waitcnt(0);
        unsigned nloc = b.st[0], nx = b.st[1];
        if (nloc == 0u) { xcd_barrier_complete(bar, b.x, nloc, nx); b.st[0] = nloc; b.st[1] = nx; }
        const unsigned old = xb_add(&bar[XB_XSUB(b.x)], 1u);
        const unsigned gen = old / nloc;
        if (old + 1u == (gen + 1u) * nloc) {
            __builtin_amdgcn_fence(__ATOMIC_RELEASE, "agent");
            asm volatile("s_waitcnt vmcnt(0)" ::: "memory");
            const unsigned og = xb_add(&bar[XB_TOP], 1u);
            const unsigned tg = og / nx;
            if (og + 1u == (tg + 1u) * nx) xb_add(&bar[XB_TOPGEN], 1u);
            else XB_SPIN(xb_ld(&bar[XB_TOPGEN]) == tg, bar);
            __builtin_amdgcn_fence(__ATOMIC_ACQUIRE, "agent");
            asm volatile("s_waitcnt vmcnt(0)" ::: "memory");
        } else {
            XB_SPIN(xb_ld(&bar[XB_TOPGEN]) == gen, bar);
            __builtin_amdgcn_fence(__ATOMIC_ACQUIRE, "agent");
            asm volatile("s_waitcnt vmcnt(0)" ::: "memory");
        }
    }
    if constexpr (JOB != 0) barrier_job<JOB>(c);
    __syncthreads();
}

__device__ __forceinline__ void cvt_item(const float* W, int K, int N, bf16* WT, bool qkperm, const float* nw, LAS float* scr, int item, int lane) {
    const int nblk = N / 32, kb = item / nblk, nb = item % nblk, k0 = 64 * kb, n0 = 32 * nb;
    float wv_[32];
#pragma unroll
    for (int i = 0; i < 32; ++i) { const int kk = 2 * i + (lane >> 5); wv_[i] = W[(size_t)(k0 + kk) * N + n0 + (lane & 31)]; }
#pragma unroll
    for (int i = 0; i < 32; ++i) { const int kk = 2 * i + (lane >> 5); scr[kk * 33 + (lane & 31)] = wv_[i]; }
    LDS_WAIT(); asm volatile("" ::: "memory");
    int rb = n0; if (qkperm && n0 < 2048) { const int c = n0 & 255; rb = (n0 & ~255) + ((c >> 5) & 1) * 128 + (c >> 6) * 32; }
    const int c = lane & 7;
    f32x4 w0 = (f32x4){1.f, 1.f, 1.f, 1.f}, w1 = w0; if (nw) { w0 = *(const GAS f32x4*)(nw + k0 + 8 * c); w1 = *(const GAS f32x4*)(nw + k0 + 8 * c + 4); }
#pragma unroll
    for (int j = 0; j < 4; ++j) { const int n = (lane >> 3) + 8 * j; const LAS float* s = scr + (8 * c) * 33 + n;
        v4u o; o.x = pk2(s[0 * 33] * w0[0], s[1 * 33] * w0[1]); o.y = pk2(s[2 * 33] * w0[2], s[3 * 33] * w0[3]); o.z = pk2(s[4 * 33] * w1[0], s[5 * 33] * w1[1]); o.w = pk2(s[6 * 33] * w1[2], s[7 * 33] * w1[3]);
        *(GAS v4u*)(WT + (size_t)(rb + n) * K + k0 + 8 * c) = o; }
    LDS_WAIT(); asm volatile("" ::: "memory");
}
__device__ __forceinline__ void cvt_pair(const float* W0, int K0, int N0, bf16* T0, bool perm0, const float* nw0, const float* W1, int K1, int N1, bf16* T1, LAS unsigned char* lds, int gw, int ngw, int wave, int lane) {
    LAS float* scr = (LAS float*)(lds + wave * 16384);
    const int i0 = (K0 / 64) * (N0 / 32), i1 = (K1 / 64) * (N1 / 32);
    for (int it = gw; it < i0 + i1; it += ngw) { if (it < i0) cvt_item(W0, K0, N0, T0, perm0, nw0, scr, it, lane); else cvt_item(W1, K1, N1, T1, false, nullptr, scr, it - i0, lane); }
}
__device__ __forceinline__ void prep_rows(const float* x, bf16* XB, float* SQ, int gw, int ngw, int lane) {
    for (int m0 = gw; m0 < M; m0 += 4 * ngw) {
        f32x4 v[4][4];
#pragma unroll
        for (int q = 0; q < 4; ++q) { const int m = m0 + q * ngw; if (m < M) { const GAS f32x4* xr = (const GAS f32x4*)(x + (size_t)m * D) + lane;
#pragma unroll
            for (int j = 0; j < 4; ++j) v[q][j] = xr[64 * j]; } }
#pragma unroll
        for (int q = 0; q < 4; ++q) { const int m = m0 + q * ngw; if (m < M) { float s = 0.f;
#pragma unroll
            for (int j = 0; j < 4; ++j) s += (v[q][j].x * v[q][j].x + v[q][j].y * v[q][j].y) + (v[q][j].z * v[q][j].z + v[q][j].w * v[q][j].w);
            const float ssum = wave_sum(s);
            GAS v2u* o8 = (GAS v2u*)(XB + (size_t)m * D) + lane;
#pragma unroll
            for (int j = 0; j < 4; ++j) { v2u o; o.x = pk2(v[q][j].x, v[q][j].y); o.y = pk2(v[q][j].z, v[q][j].w); o8[64 * j] = o; }
            if (lane == 0) *((GAS f32x4*)SQ + m) = (f32x4){ssum, 0.f, 0.f, 0.f}; } }
    }
}
struct Args { const float* in[18]; float* out; unsigned char* ws; int ph_lo, ph_hi; };
struct Ctx { LAS unsigned char* L; gu32* ctl; int wave, G, bx, vcu, gw, ngw, lo, hi; XcdBarrier bar; };
typedef __attribute__((address_space(4))) const unsigned char* kptr_t;
__device__ __forceinline__ kptr_t kargs() { kptr_t p = (kptr_t)__builtin_amdgcn_kernarg_segment_ptr(); asm volatile("" : "+s"(p)); return p; }
template <class T> __device__ __forceinline__ T kld(kptr_t p, int off) { return *(const __attribute__((address_space(4))) T*)(p + off); }
#define KP_IN(k) kld<const float*>(kp, 8 * (k))
#define PHB if (PH_ON) { const int lane = lane_now(), tid = c.wave * 64 + lane; (void)tid; const kptr_t kp = kargs(); unsigned char* const ws = kld<unsigned char*>(kp, 152); float* const xo = kld<float*>(kp, 144); (void)xo; (void)ws;
#define P_H ((bf16*)(ws + WS_H))
#define P_WIN ((bf16*)(ws + WS_WIN))
#define P_WOUT ((bf16*)(ws + WS_WOUT))
#define P_WUP ((bf16*)(ws + WS_WUP))
#define P_WDN ((bf16*)(ws + WS_WDN))
#define P_QT ((bf16*)(ws + WS_QT))
#define P_KTK ((bf16*)(ws + WS_KTK))
#define P_KF ((bf16*)(ws + WS_KF))
#define P_VT ((bf16*)(ws + WS_VT))
#define P_G ((bf16*)(ws + WS_G))
#define P_P ((bf16*)(ws + WS_P))
#define P_ST ((bf16*)xo)
#define P_SS ((float*)(ws + WS_SS))
#define P_AQ ((bf16*)(ws + WS_AQ))
#define P_AK ((bf16*)(ws + WS_AK))
#define P_AV ((bf16*)(ws + WS_AV))
#define P_OB ((bf16*)(ws + WS_OB))
#define P_Y ((bf16*)(ws + WS_Y))
#define P_KM ((bf16*)(ws + WS_KM))
#define P_U ((bf16*)(ws + WS_U))
#define P_RN ((float*)(ws + WS_RN))
#define P_SQ ((float*)(ws + WS_SQ))
#define PH_ON (ph >= c.lo && ph < c.hi)
enum { J_NONE = 0, J_UP = 1  , J_DN = 5  , J_MIX1 = 9, J_MIX2 = 10, J_MIXIN3 = 11, J_MIXOUT3 = 12 };
constexpr size_t DS_W1IN = 0, DS_W1OUT = 6 * MiB, DS_W2IN = 8 * MiB, DS_W2OUT = 14 * MiB, DS_W3IN = 16 * MiB;
template <int JOB> __device__ __forceinline__ void ph_end(const Ctx& c, int& ph) {
    if (PH_ON && ph + 1 < c.hi) { const bool t0 = (c.wave == 0) && (lane_now() == 0); if (MK_PER_PHASE) { if (t0) __hip_atomic_store(c.ctl + CW_TMO, 0xBADBA0u, RLX_AGENT); } else xcd_barrier<JOB>(c.bar, t0, c); }
    ++ph;
}
#define PH_END ph_end<J_NONE>(c, ph)
#define PH_END_J(J) ph_end<(J)>(c, ph)
template <int JOB> __device__ __forceinline__ void barrier_job(const Ctx& c) {
    if (c.wave == 0) return;
    const int lane = lane_now(); const kptr_t kp = kargs(); unsigned char* const ws = kld<unsigned char*>(kp, 152); unsigned char* const dsc = (unsigned char*)kld<float*>(kp, 144);
    const int gw7 = c.vcu * (NWAVES - 1) + (c.wave - 1), ngw7 = c.G * (NWAVES - 1);
    if constexpr (JOB >= J_UP && JOB < J_UP + 4) { constexpr int LY = JOB - J_UP;
        cvt_pair(KP_IN(4) + (size_t)LY * D * FF, D, FF, P_WUP, false, KP_IN(3) + LY * D, nullptr, 0, 0, nullptr, c.L, gw7, ngw7, c.wave, lane); }
    else if constexpr (JOB >= J_DN && JOB < J_DN + 4) { constexpr int LY = JOB - J_DN;
        cvt_pair(KP_IN(5) + (size_t)LY * FF * D, FF, D, P_WDN, false, nullptr, nullptr, 0, 0, nullptr, c.L, gw7, ngw7, c.wave, lane); }
    else if constexpr (JOB == J_MIX1) cvt_pair(KP_IN(8), D, 3 * D, (bf16*)(dsc + DS_W1IN), true, KP_IN(2) + 1 * D, KP_IN(11), D, D, (bf16*)(dsc + DS_W1OUT), c.L, gw7, ngw7, c.wave, lane);
    else if constexpr (JOB == J_MIX2) cvt_pair(KP_IN(12), D, 3 * D, (bf16*)(dsc + DS_W2IN), true, KP_IN(2) + 2 * D, KP_IN(17), D, D, (bf16*)(dsc + DS_W2OUT), c.L, gw7, ngw7, c.wave, lane);
    else if constexpr (JOB == J_MIXIN3) cvt_pair(KP_IN(6) + (size_t)1 * D * RIN, D, RIN, (bf16*)(dsc + DS_W3IN), false, KP_IN(2) + 3 * D, nullptr, 0, 0, nullptr, c.L, gw7, ngw7, c.wave, lane);
    else if constexpr (JOB == J_MIXOUT3) cvt_pair(KP_IN(7) + (size_t)1 * RH * RDV * D, RH * RDV, D, P_WOUT, false, nullptr, nullptr, 0, 0, nullptr, c.L, gw7, ngw7, c.wave, lane);
}

template <int KIND> __device__ __forceinline__ void cvt_mixer(const kptr_t kp, unsigned char* const ws, const Ctx& c, const int lane, int j, const float* nw, bf16* const win_dst) {
    if constexpr (KIND == 0) cvt_pair(KP_IN(6) + (size_t)j * D * RIN, D, RIN, win_dst, false, nw, KP_IN(7) + (size_t)j * RH * RDV * D, RH * RDV, D, P_WOUT, c.L, c.gw, c.ngw, c.wave, lane);
    else if constexpr (KIND == 1) cvt_pair(KP_IN(8), D, 3 * D, P_WIN, true, nw, KP_IN(11), D, D, P_WOUT, c.L, c.gw, c.ngw, c.wave, lane);
    else cvt_pair(KP_IN(12), D, 3 * D, P_WIN, true, nw, KP_IN(17), D, D, P_WOUT, c.L, c.gw, c.ngw, c.wave, lane);
}
#define CVT_MLP() cvt_pair(KP_IN(4) + (size_t)LAYER * D * FF, D, FF, P_WUP, false, KP_IN(3) + LAYER * D, KP_IN(5) + (size_t)LAYER * FF * D, FF, D, P_WDN, c.L, c.gw, c.ngw, c.wave, lane)

#define PRELOAD_SQ(NMAX, ROW, FUNC) { pg8::Unit u_; LAS float* tb_ = (LAS float*)(L + 139264); f32x4 a_[NMAX]; bool v_[NMAX]; \
    _Pragma("unroll") for (int i_ = 0; i_ < NMAX; ++i_) { v_[i_] = S.next(i_, u_); a_[i_] = (f32x4){1.f, 1.f, 1.f, 1.f}; if (v_[i_] && tid < 256) a_[i_] = *((const GAS f32x4*)P_SQ + ((ROW) * 256 + tid)); } \
    _Pragma("unroll") for (int i_ = 0; i_ < NMAX; ++i_) if (v_[i_] && tid < 256) tb_[i_ * 256 + tid] = FUNC(((a_[i_].x + a_[i_].y) + (a_[i_].z + a_[i_].w)) * (1.f / D) + EPS); \
    __syncthreads(); }
template <int LAYER> __device__ __forceinline__ void ret_rest(const Ctx& c, int& ph) {
    PHB
        for (int item = c.bx * (NWAVES * 64) + tid; item < 16 * 16384; item += c.G * NWAVES * 64) {
            const int bhl = item >> 14, v = item & 16383, h = bhl & 3;
            const float g256 = __builtin_amdgcn_exp2f(256.f * __builtin_amdgcn_logf(1.0f - __builtin_amdgcn_exp2f(-5.0f - (float)h)));
            GAS v4u* p = (GAS v4u*)(P_ST + (size_t)bhl * 16 * 131072) + v;
            v4u t[16];
#pragma unroll
            for (int n = 0; n < 16; ++n) t[n] = p[(size_t)n * 16384];
            float s[8] = {0.f, 0.f, 0.f, 0.f, 0.f, 0.f, 0.f, 0.f};
#pragma unroll
            for (int n = 0; n < 16; ++n) {
                v4u o; o.x = pk2(s[0], s[1]); o.y = pk2(s[2], s[3]); o.z = pk2(s[4], s[5]); o.w = pk2(s[6], s[7]);
                p[(size_t)n * 16384] = o;
                s[0] = g256 * (s[0] + bflo(t[n].x)); s[1] = g256 * (s[1] + bfhi(t[n].x)); s[2] = g256 * (s[2] + bflo(t[n].y)); s[3] = g256 * (s[3] + bfhi(t[n].y));
                s[4] = g256 * (s[4] + bflo(t[n].z)); s[5] = g256 * (s[5] + bfhi(t[n].z)); s[6] = g256 * (s[6] + bflo(t[n].w)); s[7] = g256 * (s[7] + bfhi(t[n].w));
            }
        }
    }
    PH_END_J(J_DN + LAYER);
    PHB
        pg8::SchedRetO S{(const char*)P_P, (const char*)P_QT, (const char*)P_VT, (const char*)P_ST, c.G, c.vcu};
        pg8::EpiRetOut E{P_G, P_SS};
        pg8::gemm_phase<pg8::EpiRetOut, pg8::SchedRetO, true, true>(c.L + RING_OFF, c.wave, pg8::GemmP{256, 256, 4, 4}, S, E);
    }
    PH_END;
}

template <int LAYER> __device__ __forceinline__ void do_layer(const Ctx& c, int& ph) {
    extern __shared__ __attribute__((aligned(16))) unsigned char lds[];
    constexpr int KIND = LAYER % 3, J = LAYER / 3;
    const int G = c.G, bx = c.bx, gw = c.gw, ngw = c.ngw;
    LAS unsigned char* const L = c.L;
    if constexpr (KIND == 0) {
        PHB
            pg8::SchedRetIn S{(const char*)P_H, (LAYER == 3) ? (const char*)xo + DS_W3IN : (const char*)P_WIN, G, bx};
            PRELOAD_SQ(6, (u_.ty >= 3 ? u_.pn : u_.pm), __builtin_amdgcn_rsqf)
            pg8::EpiRetIn E{P_QT, P_KTK, P_KF, P_VT, P_G, (const LAS float*)(L + 139264), L + 147456};
            pg8::gemm_phase<pg8::EpiRetIn, pg8::SchedRetIn, true, true>(L + RING_OFF, c.wave, pg8::GemmP{1024, 1024, 16, 0}, S, E);
        }
        PH_END;
        PHB
            pg8::SchedRetPS S{(const char*)P_QT, (const char*)P_KTK, (const char*)P_VT, (const char*)P_KF, G, c.vcu};
            pg8::EpiMaskState E{pg8::EpiMask{P_P}, pg8::EpiState{P_ST}};
            pg8::gemm_phase<pg8::EpiMaskState, pg8::SchedRetPS, true, true>(L + RING_OFF, c.wave, pg8::GemmP{256, 256, 4, 0}, S, E);
        }
        PH_END_J(J_UP + LAYER);
        ret_rest<LAYER>(c, ph);
        PHB
            pg8::SchedPlain S{(const char*)P_G, (const char*)P_WOUT, 64, 4, G, bx, (size_t)256 * 2048 * 2, (size_t)256 * 2048 * 2};
            { pg8::Unit u_; LAS float* tb_ = (LAS float*)(L + 139264);
              if (S.next(0, u_) && tid < 256) { float r_[4];
#pragma unroll
                  for (int h_ = 0; h_ < 4; ++h_) { const GAS f32x4* sp_ = (const GAS f32x4*)(P_SS + (size_t)((u_.pm * 256 + tid) * 4 + h_) * 8); const f32x4 s0_ = sp_[0], s1_ = sp_[1];
                      r_[h_] = __builtin_amdgcn_rsqf(((s0_.x + s0_.y) + (s0_.z + s0_.w) + (s1_.x + s1_.y) + (s1_.z + s1_.w)) * (1.f / 512.f) + EPS); }
                  tb_[tid] = r_[0] / r_[1]; tb_[256 + tid] = r_[1] / r_[2]; tb_[512 + tid] = r_[2] / r_[3]; tb_[768 + tid] = r_[3]; }
              __syncthreads(); }
            pg8::EpiResH E{P_H, xo, P_SQ, (LAS float*)(L + 135168), (const LAS float*)(L + 139264)};
            pg8::gemm_phase<pg8::EpiResH, pg8::SchedPlain, true, true>(L + RING_OFF, c.wave, pg8::GemmP{2048, 2048, 32, 0}, S, E);
        }
        PH_END_J(LAYER == 0 ? J_MIX1 : J_NONE);
    } else {
        PHB
            pg8::SchedPlain S{(const char*)P_H, (const char*)xo + (KIND == 1 ? DS_W1IN : DS_W2IN), 64, 12, G, bx, (size_t)256 * 1024 * 2, (size_t)256 * 1024 * 2};
            PRELOAD_SQ(3, u_.pm, __builtin_amdgcn_rsqf)
            if (KIND == 1) ((LAS float*)(L + 135168))[tid] = 0.f;
            pg8::EpiQKNorm<KIND == 1> E{P_AQ, P_AK, P_AV, (KIND == 1) ? KP_IN(9) : KP_IN(13), (KIND == 1) ? KP_IN(10) : KP_IN(14), (const LAS float*)(L + 139264), (KIND == 1) ? (pg8::bf16_t*)P_KM : nullptr, (LAS float*)(L + 135168)};
            pg8::gemm_phase<pg8::EpiQKNorm<KIND == 1>, pg8::SchedPlain, true, true>(L + RING_OFF, c.wave, pg8::GemmP{1024, 1024, 16, 0}, S, E);
        }
        PH_END_J(KIND == 2 ? J_MIXIN3 : J_UP + LAYER);
        const int abh = c.vcu >> 2, as_ = c.vcu & 3, ab = abh >> 4, ah = abh & 15;
        if constexpr (KIND == 1) {
        PHB
            if (G == 256) {
                const float* const rel_bias = KP_IN(1);
                LAS float* tab = (LAS float*)(L + attn_body::LDS_TAB);
                for (int xx = tid; xx < attn_body::TAB_N; xx += NWAVES * 64) { const int d = xx - 256; float v = 0.f;
                    if (d >= 0) { int bk = d; if (d >= 16) { bk = 16 + (d >= 21) + (d >= 27) + (d >= 35) + (d >= 46) + (d >= 59) + (d >= 77) + (d >= 99) + (d >= 128) + (d >= 166) + (d >= 216) + (d >= 280) + (d >= 363) + (d >= 470) + (d >= 609) + (d >= 790); }
                        v = (rel_bias[bk * 16 + ah] - rel_bias[31 * 16 + ah]) * LOG2E; }
                    tab[xx] = v; }
                __syncthreads();
                for (int i = 0; i < 4; ++i) { const int qb = (i == 0) ? as_ : (i == 1) ? 7 - as_ : (i == 2) ? 8 + as_ : 15 - as_;
                    attn_body::attn_unit<1, 8, 1024>(ab, qb, (const attn_body::bf16*)P_AQ, ah * 64, (const attn_body::bf16*)P_AK, ah * 64, (const attn_body::bf16*)P_AV, ah * 64,
                                               (attn_body::bf16*)P_OB, ah * 64, (const attn_body::bf16*)P_KM + (size_t)ab * 64 * 1024 + ah * 64, (char*)lds, c.wave);
                }
            }
        }
        PH_END_J(J_DN + LAYER);
        } else {
        PHB
            if (G == 256) {
                const int pr_ = c.vcu >> 3, as8 = c.vcu & 7, ab2 = pr_ >> 3, hd2 = pr_ & 7;
                const float* const rel_bias = KP_IN(1);
                LAS float* tab = (LAS float*)(L + attn_body::V2_TAB);
                for (int hh = 0; hh < 2; ++hh) { const int ah = 2 * hd2 + hh;
                    __syncthreads();
                for (int xx = tid; xx < attn_body::TAB_N; xx += NWAVES * 64) { const int d = xx - 256; float v = 0.f;
                    if (d >= 0) { int bk = d; if (d >= 16) { bk = 16 + (d >= 21) + (d >= 27) + (d >= 35) + (d >= 46) + (d >= 59) + (d >= 77) + (d >= 99) + (d >= 128) + (d >= 166) + (d >= 216) + (d >= 280) + (d >= 363) + (d >= 470) + (d >= 609) + (d >= 790); }
                        v = (rel_bias[bk * 16 + ah] - rel_bias[31 * 16 + ah]) * LOG2E; }
                    tab[xx] = v; }
                    __syncthreads();
                    for (int i = 0; i < 2; ++i) { const int qb = i ? 15 - as8 : as8;
                        attn_body::attn_unit_v128<8>(ab2, qb, (const attn_body::bf16*)P_AQ, ah * 64, (const attn_body::bf16*)P_AK, ah * 64, (const attn_body::bf16*)P_AV, hd2 * 128,
                                                     (attn_body::bf16*)P_OB, ah * 128, (char*)lds, c.wave);
                    }
                }
                asm volatile("s_waitcnt vmcnt(0)" ::: "memory"); __syncthreads();
                __builtin_amdgcn_fence(__ATOMIC_ACQUIRE, "agent"); asm volatile("s_waitcnt vmcnt(0)" ::: "memory");
                const int ln_ = lane_now();
                const float* lam = KP_IN(15); const float* subln = KP_IN(16);
                const float linit = 0.8f - 0.6f * 0.5488116360940264f;
                const float s01 = wave_sum(lam[ln_] * lam[64 + ln_]), s23 = wave_sum(lam[128 + ln_] * lam[192 + ln_]);
                const float lfull = __builtin_amdgcn_exp2f(s01 * LOG2E) - __builtin_amdgcn_exp2f(s23 * LOG2E) + linit;
                const int seg = ln_ & 7;
                f32x4 sw[4];
#pragma unroll
                for (int j = 0; j < 4; ++j) sw[j] = *((const GAS f32x4*)(subln + seg * 16) + j);
                for (int hf = 0; hf < 2; ++hf) { const int qb = hf ? 15 - as8 : as8; const size_t m0 = (size_t)ab2 * SEQ + qb * 256 + c.wave * 8 + (ln_ >> 3);
                    v4u u1[4][2], u2[4][2];
#pragma unroll
                    for (int q = 0; q < 4; ++q) { const size_t m = m0 + q * 64;
                        const GAS v4u* p1 = (const GAS v4u*)(P_OB + m * 2048 + (2 * hd2) * 128 + seg * 16);
                        const GAS v4u* p2 = (const GAS v4u*)(P_OB + m * 2048 + (2 * hd2 + 1) * 128 + seg * 16);
#pragma unroll
                        for (int j = 0; j < 2; ++j) { u1[q][j] = p1[j]; u2[q][j] = p2[j]; } }
#pragma unroll
                    for (int q = 0; q < 4; ++q) { const size_t m = m0 + q * 64;
                        float a[16]; float ss = 0.f;
#pragma unroll
                        for (int j = 0; j < 2; ++j) { const v4u w1 = u1[q][j], w2 = u2[q][j];
                            a[8 * j + 0] = bflo(w1.x) - lfull * bflo(w2.x); a[8 * j + 1] = bfhi(w1.x) - lfull * bfhi(w2.x); a[8 * j + 2] = bflo(w1.y) - lfull * bflo(w2.y); a[8 * j + 3] = bfhi(w1.y) - lfull * bfhi(w2.y);
                            a[8 * j + 4] = bflo(w1.z) - lfull * bflo(w2.z); a[8 * j + 5] = bfhi(w1.z) - lfull * bfhi(w2.z); a[8 * j + 6] = bflo(w1.w) - lfull * bflo(w2.w); a[8 * j + 7] = bfhi(w1.w) - lfull * bfhi(w2.w); }
#pragma unroll
                        for (int j = 0; j < 16; ++j) ss += a[j] * a[j];
                        ss += __shfl_xor(ss, 1); ss += __shfl_xor(ss, 2); ss += __shfl_xor(ss, 4);
                        const float r = __builtin_amdgcn_rsqf(ss * (1.f / 128.f) + EPS) * (1.0f - linit);
                        GAS v4u* po = (GAS v4u*)(P_Y + m * 1024 + hd2 * 128 + seg * 16);
#pragma unroll
                        for (int j = 0; j < 2; ++j) { v4u o;
                            o.x = pk2(a[8 * j + 0] * r * sw[2 * j][0], a[8 * j + 1] * r * sw[2 * j][1]); o.y = pk2(a[8 * j + 2] * r * sw[2 * j][2], a[8 * j + 3] * r * sw[2 * j][3]);
                            o.z = pk2(a[8 * j + 4] * r * sw[2 * j + 1][0], a[8 * j + 5] * r * sw[2 * j + 1][1]); o.w = pk2(a[8 * j + 6] * r * sw[2 * j + 1][2], a[8 * j + 7] * r * sw[2 * j + 1][3]); po[j] = o; }
                    }
                }
            }
        }
        PH_END_J(J_UP + LAYER);
        }
        PHB
            pg8::SchedPlain S{(const char*)((KIND == 1) ? P_OB : P_Y), (const char*)xo + (KIND == 1 ? DS_W1OUT : DS_W2OUT), 64, 4, G, bx, (size_t)256 * 1024 * 2, (size_t)256 * 1024 * 2};
            pg8::EpiRes<false> E{P_H, xo, P_SQ, (LAS float*)(L + 135168)};
            pg8::gemm_phase<pg8::EpiRes<false>, pg8::SchedPlain, true, true>(L + RING_OFF, c.wave, pg8::GemmP{1024, 1024, 16, 0}, S, E);
        }
        PH_END_J(KIND == 1 ? J_MIX2 : J_DN + LAYER);
    }
    PHB
        pg8::SchedPlain S{(const char*)P_H, (const char*)P_WUP, 64, 16, G, bx, (size_t)256 * 1024 * 2, (size_t)256 * 1024 * 2};
        PRELOAD_SQ(4, u_.pm, __builtin_amdgcn_rcpf)
        pg8::EpiUp E{P_U, (const LAS float*)(L + 139264)};
        pg8::gemm_phase<pg8::EpiUp, pg8::SchedPlain, true, true>(L + RING_OFF, c.wave, pg8::GemmP{1024, 1024, 16, 0}, S, E);
    }
    PH_END_J(LAYER == 2 ? J_MIXOUT3 : J_NONE);
    PHB
        pg8::SchedPlain S{(const char*)P_U, (const char*)P_WDN, 64, 4, G, bx, (size_t)256 * 4096 * 2, (size_t)256 * 4096 * 2};
        pg8::EpiRes<(LAYER == 3)> E{P_H, xo, P_SQ, (LAS float*)(L + 135168)};
        pg8::gemm_phase<pg8::EpiRes<(LAYER == 3)>, pg8::SchedPlain, true, true>(L + RING_OFF, c.wave, pg8::GemmP{4096, 4096, 64, 0}, S, E);
    }
    PH_END;
}

__global__ void __launch_bounds__(NWAVES * 64, 2) trunk_fwd(Args args) {
    extern __shared__ __attribute__((aligned(16))) unsigned char lds[];
    Ctx c;
    c.L = (LAS unsigned char*)lds;
    volatile LAS unsigned* const MISC = (volatile LAS unsigned*)(c.L + MISC_OFF);
    const int tid0 = threadIdx.x; c.wave = __builtin_amdgcn_readfirstlane(tid0 >> 6);
    c.G = gridDim.x; c.bx = blockIdx.x;
    c.vcu = (c.G % 8 == 0) ? (c.bx % 8) * (c.G / 8) + c.bx / 8 : c.bx;
    c.gw = c.vcu * NWAVES + c.wave; c.ngw = c.G * NWAVES;
    c.ctl = (gu32*)(args.ws + WS_CTL);
    for (int u = tid0; u < (LDS_BYTES - LDSCTL_OFF) / 4; u += NWAVES * 64) ((LAS unsigned*)(c.L + LDSCTL_OFF))[u] = 0u;
    __syncthreads();
    c.bar.bar = (unsigned*)(c.ctl + CW_BAR); c.bar.x = 0; c.bar.st = nullptr;
    if (!MK_PER_PHASE) c.bar = xcd_barrier_post((unsigned*)(c.ctl + CW_BAR), MISC + 8, tid0 == 0);
    c.lo = args.ph_lo; c.hi = args.ph_hi;
    int ph = 0;
    PHB cvt_mixer<0>(kp, ws, c, lane, 0, KP_IN(2), P_WIN); prep_rows(KP_IN(0), P_H, P_SQ, c.gw, c.ngw, lane);
        for (int i = c.bx * (NWAVES * 64) + tid; i < 4 * 48 * 128; i += c.G * NWAVES * 64) { const int b = i / (48 * 128), r = (i / 128) % 48, cc = i % 128;
            *((GAS v4u*)(P_KM + ((size_t)(b * 64 + 16 + r)) * 1024) + cc) = (v4u){0u, 0u, 0u, 0u}; } }
    PH_END;
    do_layer<0>(c, ph);
    do_layer<1>(c, ph);
    do_layer<2>(c, ph);
    do_layer<3>(c, ph);
}
#undef PH_ON
#undef PH_END


constexpr int N_PHASES = 1 + (5 + 2) + (3 + 2) + (3 + 2) + (5 + 2);
extern "C" void kernel_launch(void* const* d_in, const int* in_sizes, int n_in, void* d_out, int out_size, void* d_ws, size_t ws_size, hipStream_t stream) {
    static int grid = 0;
    if (grid == 0) {
        if (n_in != 18 || in_sizes[0] != M * D || out_size != M * D || ws_size < WS_END) { fprintf(stderr, "kernel_launch: unexpected shapes (n_in %d, in0 %d, out %d, ws %zu < %zu); nothing launched\n", n_in, n_in > 0 ? in_sizes[0] : -1, out_size, ws_size, (size_t)WS_END); grid = -1; return; }
        int dev = 0, cus = 0, per_cu = 0;
        if (hipGetDevice(&dev) != hipSuccess || hipDeviceGetAttribute(&cus, hipDeviceAttributeMultiprocessorCount, dev) != hipSuccess) { grid = -1; return; }
        if (hipFuncSetAttribute((const void*)trunk_fwd, hipFuncAttributeMaxDynamicSharedMemorySize, LDS_BYTES) != hipSuccess) { fprintf(stderr, "kernel_launch: hipFuncSetAttribute failed\n"); grid = -1; return; }
        if (hipOccupancyMaxActiveBlocksPerMultiprocessor(&per_cu, (const void*)trunk_fwd, NWAVES * 64, LDS_BYTES) != hipSuccess || per_cu < 1)
            fprintf(stderr, "kernel_launch: note: occupancy query reports %d workgroups per CU\n", per_cu);
        (void)hipGetLastError();
        grid = cus;
        if (grid != 256) fprintf(stderr, "kernel_launch: %d CUs; the attention phases need a 256-workgroup grid\n", grid);
    }
    if (grid < 0) return;
    if (hipMemsetAsync((char*)d_ws + WS_CTL, 0, CTL_ZERO_BYTES, stream) != hipSuccess) return;
    Args a{};
    for (int i = 0; i < 18; ++i) a.in[i] = (const float*)d_in[i];
    a.out = (float*)d_out; a.ws = (unsigned char*)d_ws;
#if MK_PER_PHASE
    for (int p = 0; p < N_PHASES; ++p) { a.ph_lo = p; a.ph_hi = p + 1; hipLaunchKernelGGL(trunk_fwd, dim3(grid), dim3(NWAVES * 64), LDS_BYTES, stream, a); }
#else
    a.ph_lo = 0; a.ph_hi = N_PHASES;
    hipLaunchKernelGGL(trunk_fwd, dim3(grid), dim3(NWAVES * 64), LDS_BYTES, stream, a);
#endif
    const hipError_t le = hipPeekAtLastError();
    if (le != hipSuccess) fprintf(stderr, "kernel_launch: launch failed: %s\n", hipGetErrorName(le));
}
```

```cpp
#include <hip/hip_runtime.h>
#include <hip/hip_bf16.h>
#include <cstdio>
#include <cstdint>

__device__ __forceinline__ int lane_now() { int l; asm volatile("v_mbcnt_lo_u32_b32 %0, -1, 0\n\tv_mbcnt_hi_u32_b32 %0, -1, %0" : "=v"(l)); return l; }

#ifndef MK_PER_PHASE
#define MK_PER_PHASE 0
#endif

namespace pg8 {
#define PG8_LAS __attribute__((address_space(3)))
typedef unsigned short bf16_t;
typedef short bf16x8 __attribute__((ext_vector_type(8)));
typedef float f32x4 __attribute__((ext_vector_type(4)));
typedef unsigned u32x4 __attribute__((ext_vector_type(4)));
constexpr int BM = 256, BK = 64, HALF = 128, HTB = HALF * BK * 2  , STAGE_BYTES = 8 * HTB, NXCD = 8, WGM = 8;

__host__ __device__ __forceinline__ int lds_byte(int r, int c) { const int st = (r >> 4) * 2 + (c >> 5), rr = r & 15, cc = c & 31, ob = rr * 64 + cc * 2; return st * 1024 + (ob ^ (((ob >> 9) & 1) << 5)); }
__host__ __device__ __forceinline__ void stage_rc(int b, int& R, int& C) { const int st = b / 1024, sb = b % 1024, swz = sb ^ (((sb >> 9) & 1) << 5); R = (st >> 1) * 16 + swz / 64; C = (st & 1) * 32 + (swz % 64) / 2; }
__host__ __device__ __forceinline__ int perm32(int rho) { const int n = rho >> 4, i = rho & 15; return 8 * (i >> 2) + 4 * n + (i & 3); }

struct Unit { const char* a0; const char* b0; const char* a1; const char* b1; int pm, pn, ty, z; };
struct GemmP { int lda, ldb, nt1, nt2; };

__host__ __device__ __forceinline__ void tile_of(int L, int nM, int nN, int& pm, int& pn) {
    const int nwg = nM * nN; int wgid = L; { const int q = nwg / NXCD, r = nwg % NXCD, xcd = wgid % NXCD, off = wgid / NXCD; wgid = (xcd < r ? xcd * (q + 1) : r * (q + 1) + (xcd - r) * q) + off; }
    const int nig = WGM * nN, gid = wgid / nig, fm = gid * WGM, gsz = (nM - fm) < WGM ? (nM - fm) : WGM;
    pm = fm + ((wgid % nig) % gsz); pn = (wgid % nig) / gsz;
}

__device__ __forceinline__ unsigned cvt_pk_bf16(float lo, float hi) { unsigned r; asm volatile("v_cvt_pk_bf16_f32 %0, %1, %2" : "=v"(r) : "v"(lo), "v"(hi)); return r; }
__device__ __forceinline__ u32x4 pack8(const f32x4 v0, const f32x4 v1) { u32x4 w; w.x = cvt_pk_bf16(v0[0], v0[1]); w.y = cvt_pk_bf16(v0[2], v0[3]); w.z = cvt_pk_bf16(v1[0], v1[1]); w.w = cvt_pk_bf16(v1[2], v1[3]); return w; }

template <class Epi, class Sched, bool ALIGN_EPI, bool SP2>
__device__ __forceinline__ void gemm_phase(PG8_LAS unsigned char* lds, const int wave, const GemmP g, const Sched& S, const Epi& E) {
    const int lane = lane_now(), wid = wave, tid = wave * 64 + lane, wr = wid >> 2, wc = wid & 3, fr = lane & 15, fq = lane >> 4;
    const int nt1 = g.nt1, nt = g.nt1 + g.nt2;
    unsigned voffA[2], voffB[2];
#pragma unroll
    for (int i = 0; i < 2; ++i) { int R, C; stage_rc(tid * 16 + i * 8192, R, C); const int Rb = Epi::PERM ? ((R & ~31) + perm32(R & 31)) : R;
        voffA[i] = (unsigned)(R * g.lda + C) * 2u; voffB[i] = (unsigned)(Rb * g.ldb + C) * 2u; }
    const size_t kstep = (size_t)(BK * 2);
    const size_t hstepA = (size_t)HALF * g.lda * 2, hstepB = (size_t)HALF * g.ldb * 2;
    const unsigned ldsw = (unsigned)wid * 1024u;
    const int aoff = lds_byte(wr * 64 + fr, fq * 8), boff = lds_byte(wc * 32 + fr, fq * 8);
#define PG8_SA(b, h) (((b) * 2 + (h)) * HTB)
#define PG8_SB(b, h) ((4 + (b) * 2 + (h)) * HTB)
#define PG8_STAGE(bufoff, gbase, voff) do { _Pragma("unroll") for (int _i = 0; _i < 2; ++_i) \
        __builtin_amdgcn_global_load_lds((const unsigned*)((const char*)(gbase) + (voff)[_i]), (PG8_LAS unsigned*)(lds + (bufoff) + ldsw + _i * 8192), 16, 0, 0); } while (0)
#define PG8_LDA(dst, b, h) do { _Pragma("unroll") for (int m = 0; m < 4; ++m) _Pragma("unroll") for (int k = 0; k < 2; ++k) dst[m][k] = *(const PG8_LAS bf16x8*)(lds + PG8_SA(b, h) + aoff + m * 2048 + k * 1024); } while (0)
#define PG8_LDB(dst, b, h) do { _Pragma("unroll") for (int n = 0; n < 2; ++n) _Pragma("unroll") for (int k = 0; k < 2; ++k) dst[n][k] = *(const PG8_LAS bf16x8*)(lds + PG8_SB(b, h) + boff + n * 2048 + k * 1024); } while (0)
#define PG8_MMA(ai, bj, At, Bt) do { __builtin_amdgcn_s_setprio(1); _Pragma("unroll") for (int m = 0; m < 4; ++m) _Pragma("unroll") for (int n = 0; n < 2; ++n) _Pragma("unroll") for (int k = 0; k < 2; ++k) \
        acc[ai][bj][m][n] = __builtin_amdgcn_mfma_f32_16x16x32_bf16(Bt[n][k], At[m][k], acc[ai][bj][m][n], 0, 0, 0); __builtin_amdgcn_s_setprio(0); } while (0)
#define PG8_WAIT_V(n) asm volatile("s_waitcnt vmcnt(" #n ")" ::: "memory")
#define PG8_WAIT_L(n) asm volatile("s_waitcnt lgkmcnt(" #n ")" ::: "memory")
#define PG8_BAR __builtin_amdgcn_s_barrier()
#define PG8_SCHED __builtin_amdgcn_sched_barrier(0)
    Unit cur, nxt; int ui = 0;
    if (!S.next(0, cur)) return;
    f32x4 acc[2][2][4][2];
#pragma unroll
    for (int a = 0; a < 2; ++a)
#pragma unroll
        for (int b = 0; b < 2; ++b)
#pragma unroll
            for (int m = 0; m < 4; ++m)
#pragma unroll
                for (int n = 0; n < 2; ++n) acc[a][b][m][n] = (f32x4){0.f, 0.f, 0.f, 0.f};
    bf16x8 At[4][2], B0[2][2], B1[2][2];
    const char* cA = cur.a0; const char* cB = cur.b0;
    if constexpr (SP2) {
        PG8_STAGE(PG8_SB(0, 0), cB, voffB); PG8_STAGE(PG8_SB(0, 1), cB + hstepB, voffB); PG8_STAGE(PG8_SA(0, 0), cA, voffA); PG8_STAGE(PG8_SA(0, 1), cA + hstepA, voffA);
        if (wr == 1) PG8_BAR;
        PG8_WAIT_V(2); PG8_BAR;
        PG8_STAGE(PG8_SB(1, 0), cB + kstep, voffB); PG8_STAGE(PG8_SA(1, 0), cA + kstep, voffA); PG8_STAGE(PG8_SB(1, 1), cB + hstepB + kstep, voffB);
        PG8_WAIT_V(6); PG8_BAR;
    } else {
        PG8_STAGE(PG8_SB(0, 0), cB, voffB); PG8_STAGE(PG8_SA(0, 0), cA, voffA); PG8_STAGE(PG8_SB(0, 1), cB + hstepB, voffB); PG8_STAGE(PG8_SA(0, 1), cA + hstepA, voffA);
        if (wr == 1) PG8_BAR;
        PG8_WAIT_V(4); PG8_BAR;
        PG8_STAGE(PG8_SB(1, 0), cB + kstep, voffB); PG8_STAGE(PG8_SA(1, 0), cA + kstep, voffA); PG8_STAGE(PG8_SB(1, 1), cB + hstepB + kstep, voffB);
        PG8_WAIT_V(6); PG8_BAR;
    }
    for (;;) {
        const bool has_next = S.next(ui + 1, nxt);
        const char* nA = has_next ? nxt.a0 : cur.a0; const char* nB = has_next ? nxt.b0 : cur.b0;
        for (int t = 0; t < nt; t += 2) {
            if constexpr (Epi::KHOOK) { if (t > 0 && (t & 7) == 0) E.khook(acc, t >> 3, wr, fr); }
            const bool last = (t == nt - 2);
            const bool s1 = (t >= nt1), s2 = (t + 2 >= nt1);
            const char* a1 = s1 ? cur.a1 + (size_t)(t + 1 - nt1) * kstep : cur.a0 + (size_t)(t + 1) * kstep;
            const char* a2 = last ? nA : (s2 ? cur.a1 + (size_t)(t + 2 - nt1) * kstep : cur.a0 + (size_t)(t + 2) * kstep);
            const char* b2 = last ? nB : (s2 ? cur.b1 + (size_t)(t + 2 - nt1) * kstep : cur.b0 + (size_t)(t + 2) * kstep);
            const char* a3 = a2 + kstep; const char* b3 = b2 + kstep;
            if constexpr (SP2) {
            PG8_LDB(B0, 0, 0); PG8_LDB(B1, 0, 1); PG8_SCHED; PG8_LDA(At, 0, 0); PG8_STAGE(PG8_SA(1, 1), a1 + hstepA, voffA);
            PG8_WAIT_V(8); PG8_WAIT_L(0); PG8_BAR; PG8_MMA(0, 0, At, B0); PG8_MMA(0, 1, At, B1); PG8_BAR; PG8_SCHED;
            PG8_LDA(At, 0, 1); PG8_STAGE(PG8_SB(0, 0), b2, voffB); PG8_STAGE(PG8_SB(0, 1), b2 + hstepB, voffB); PG8_STAGE(PG8_SA(0, 0), a2, voffA);
            PG8_WAIT_V(8); PG8_WAIT_L(0); PG8_BAR; PG8_MMA(1, 0, At, B0); PG8_MMA(1, 1, At, B1); PG8_BAR; PG8_SCHED;
            PG8_LDB(B0, 1, 0); PG8_LDB(B1, 1, 1); PG8_SCHED; PG8_LDA(At, 1, 0); PG8_STAGE(PG8_SA(0, 1), a2 + hstepA, voffA);
            PG8_WAIT_V(8); PG8_WAIT_L(0); PG8_BAR; PG8_MMA(0, 0, At, B0); PG8_MMA(0, 1, At, B1); PG8_BAR; PG8_SCHED;
            PG8_LDA(At, 1, 1); PG8_STAGE(PG8_SB(1, 0), b3, voffB); PG8_STAGE(PG8_SB(1, 1), b3 + hstepB, voffB); PG8_STAGE(PG8_SA(1, 0), a3, voffA);
            PG8_WAIT_V(8); PG8_WAIT_L(0); PG8_BAR; PG8_MMA(1, 0, At, B0); PG8_MMA(1, 1, At, B1); PG8_BAR; PG8_SCHED;
            } else {
            PG8_LDB(B0, 0, 0); PG8_SCHED; PG8_LDA(At, 0, 0); PG8_STAGE(PG8_SA(1, 1), a1 + hstepA, voffA);
            PG8_WAIT_L(8); PG8_BAR; PG8_WAIT_L(0); PG8_MMA(0, 0, At, B0); PG8_BAR; PG8_SCHED;
            PG8_LDB(B1, 0, 1); PG8_STAGE(PG8_SB(0, 0), b2, voffB);
            PG8_BAR; PG8_WAIT_L(0); PG8_MMA(0, 1, At, B1); PG8_BAR;
            PG8_LDA(At, 0, 1); PG8_STAGE(PG8_SA(0, 0), a2, voffA);
            PG8_BAR; PG8_WAIT_L(0); PG8_MMA(1, 0, At, B0); PG8_BAR; PG8_SCHED;
            PG8_STAGE(PG8_SB(0, 1), b2 + hstepB, voffB);
            PG8_WAIT_V(6); PG8_BAR; PG8_MMA(1, 1, At, B1); PG8_BAR;
            PG8_LDB(B0, 1, 0); PG8_SCHED; PG8_LDA(At, 1, 0); PG8_STAGE(PG8_SA(0, 1), a2 + hstepA, voffA);
            PG8_WAIT_L(8); PG8_BAR; PG8_WAIT_L(0); PG8_MMA(0, 0, At, B0); PG8_BAR; PG8_SCHED;
            PG8_LDB(B1, 1, 1); PG8_STAGE(PG8_SB(1, 0), b3, voffB);
            PG8_BAR; PG8_WAIT_L(0); PG8_MMA(0, 1, At, B1); PG8_BAR;
            PG8_LDA(At, 1, 1); PG8_STAGE(PG8_SA(1, 0), a3, voffA);
            PG8_BAR; PG8_WAIT_L(0); PG8_MMA(1, 0, At, B0); PG8_BAR; PG8_SCHED;
            PG8_STAGE(PG8_SB(1, 1), b3 + hstepB, voffB);
            PG8_WAIT_V(6); PG8_BAR; PG8_MMA(1, 1, At, B1); PG8_BAR;
            }
        }
        if constexpr (ALIGN_EPI) { if (wr == 0) PG8_BAR; }
        E(acc, cur, wr, wc, fr, fq);
        if (!has_next) break;
#pragma unroll
        for (int a = 0; a < 2; ++a)
#pragma unroll
            for (int b = 0; b < 2; ++b)
#pragma unroll
                for (int m = 0; m < 4; ++m)
#pragma unroll
                    for (int n = 0; n < 2; ++n) acc[a][b][m][n] = (f32x4){0.f, 0.f, 0.f, 0.f};
        cur = nxt; ++ui;
        if constexpr (ALIGN_EPI) { if (wr == 1) PG8_BAR; }
    }
    PG8_WAIT_V(0);
    if constexpr (!ALIGN_EPI) { if (wr == 0) PG8_BAR; }
    PG8_BAR;
#undef PG8_SA
#undef PG8_SB
#undef PG8_STAGE
#undef PG8_LDA
#undef PG8_LDB
#undef PG8_MMA
#undef PG8_WAIT_V
#undef PG8_WAIT_L
#undef PG8_BAR
#undef PG8_SCHED
}
}

constexpr int NWAVES = 8;
constexpr int BATCH = 4, SEQ = 4096, D = 1024, FF = 4096, M = BATCH * SEQ;
constexpr int RH = 4, RDK = 256, RDV = 512, RIN = 2 * RH * RDK + 2 * RH * RDV  , RCH = 256  , RNC = SEQ / RCH  ;
constexpr int AH = 16, HD = 64;
constexpr float EPS = 1e-6f;
constexpr float LOG2E = 1.4426950408889634f;

constexpr size_t MiB = 1u << 20;
constexpr size_t WS_CTL = 0, CTL_ZERO_BYTES = 1 * MiB;
constexpr size_t WS_W = 1 * MiB;
constexpr size_t WS_WIN = WS_W, WS_WOUT = WS_W + 16 * MiB, WS_WUP = WS_W, WS_WDN = WS_W + 8 * MiB;
constexpr size_t WS_KM = 21 * MiB;
constexpr size_t WS_RN = 21 * MiB + 512 * 1024;
constexpr size_t WS_SQ = 22 * MiB;
constexpr size_t WS_SS = 23 * MiB;
constexpr size_t WS_BIG = 25 * MiB;
constexpr size_t WS_H = WS_BIG;
constexpr size_t WS_U = WS_BIG + 32 * MiB;
constexpr size_t WS_QT = WS_BIG + 32 * MiB, WS_KTK = WS_BIG + 64 * MiB, WS_P = WS_KTK  , WS_KF = WS_BIG + 96 * MiB, WS_VT = WS_BIG + 128 * MiB, WS_G = WS_BIG + 192 * MiB;
constexpr size_t WS_AQ = WS_BIG + 32 * MiB, WS_AK = WS_BIG + 64 * MiB, WS_AV = WS_BIG + 96 * MiB, WS_OB = WS_BIG + 128 * MiB, WS_Y = WS_AQ;
constexpr size_t WS_END = WS_BIG + 256 * MiB;
constexpr int CW_TMO = 0, CW_BAR = 4096;

constexpr int RING_OFF = 0, RING_BYTES = 131072;
constexpr int LDSCTL_OFF = RING_BYTES, MISC_OFF = LDSCTL_OFF + 320;
constexpr int LDS_BYTES = 163840;

#define GAS __attribute__((address_space(1)))
#define LAS __attribute__((address_space(3)))
typedef unsigned short bf16;
typedef unsigned v4u __attribute__((ext_vector_type(4)));
typedef unsigned v2u __attribute__((ext_vector_type(2)));
typedef float f32x4 __attribute__((ext_vector_type(4)));
typedef GAS unsigned gu32;
#define RLX_AGENT __ATOMIC_RELAXED, __HIP_MEMORY_SCOPE_AGENT
#define LDS_WAIT() asm volatile("s_waitcnt lgkmcnt(0)" ::: "memory")
#define VM_WAIT() asm volatile("s_waitcnt vmcnt(0)" ::: "memory")
__device__ __forceinline__ unsigned f2bf(float f) { unsigned u = __builtin_bit_cast(unsigned, f); return (u + 0x7fffu + ((u >> 16) & 1u)) >> 16; }
__device__ __forceinline__ unsigned pk2(float lo, float hi) { return f2bf(lo) | (f2bf(hi) << 16); }
__device__ __forceinline__ float bflo(unsigned w) { return __builtin_bit_cast(float, w << 16); }
__device__ __forceinline__ float bfhi(unsigned w) { return __builtin_bit_cast(float, w & 0xffff0000u); }
__device__ __forceinline__ float wave_sum(float v) {
#pragma unroll
    for (int o = 1; o < 64; o <<= 1) v += __shfl_xor(v, o);
    return v;
}

namespace pg8 {
__device__ __forceinline__ float row16_sum(float v) {
    v += __builtin_bit_cast(float, __builtin_amdgcn_update_dpp(0, __builtin_bit_cast(int, v), 0xB1, 0xF, 0xF, true));
    v += __builtin_bit_cast(float, __builtin_amdgcn_update_dpp(0, __builtin_bit_cast(int, v), 0x4E, 0xF, 0xF, true));
    v += __builtin_bit_cast(float, __builtin_amdgcn_update_dpp(0, __builtin_bit_cast(int, v), 0x141, 0xF, 0xF, true));
    v += __builtin_bit_cast(float, __builtin_amdgcn_update_dpp(0, __builtin_bit_cast(int, v), 0x140, 0xF, 0xF, true));
    return v;
}
struct EpiRetIn {
    static constexpr bool PERM = true, KHOOK = false;
    bf16_t *QT, *KTK, *KF, *VT, *G; const PG8_LAS float* RN; PG8_LAS unsigned char* tsc;
    __device__ __forceinline__ void operator()(f32x4 (&acc)[2][2][4][2], const Unit& u, int wr, int wc, int fr, int fq) const {
        asm volatile("" : "+v"(fr), "+v"(fq));
        const float RL = 13.287712379549449f / 128.f, I2PI = 0.15915494309189535f;
        if (u.ty == 2) {
            bf16_t* base = G + (size_t)(u.pm * 256 + wr * 64 + fr) * 2048 + (u.pn - 8) * 256 + wc * 32 + 8 * fq;
#pragma unroll
            for (int ai = 0; ai < 2; ++ai)
#pragma unroll
                for (int m = 0; m < 4; ++m) { const float rn = RN[u.z * 256 + ai * 128 + wr * 64 + m * 16 + fr];
#pragma unroll
                    for (int bj = 0; bj < 2; ++bj) *(u32x4*)(base + (size_t)(ai * 128 + m * 16) * 2048 + bj * 128) = pack8(acc[ai][bj][m][0] * rn, acc[ai][bj][m][1] * rn); }
        } else if (u.ty == 4) {
            const int vt = u.pm, h = vt >> 1, half = vt & 1, b = u.pn >> 4, nc = u.pn & 15;
            bf16_t* base = VT + ((size_t)(((b * 4 + h) * 16 + nc) * 512 + half * 256 + wr * 64 + fr)) * 256 + wc * 32 + 8 * fq;
            f32x4 rc[2][2];
#pragma unroll
            for (int bj = 0; bj < 2; ++bj)
#pragma unroll
                for (int n = 0; n < 2; ++n) rc[bj][n] = *(const PG8_LAS f32x4*)(RN + u.z * 256 + bj * 128 + wc * 32 + 8 * fq + 4 * n);
#pragma unroll
            for (int ai = 0; ai < 2; ++ai)
#pragma unroll
                for (int m = 0; m < 4; ++m)
#pragma unroll
                    for (int bj = 0; bj < 2; ++bj) *(u32x4*)(base + (size_t)(ai * 128 + m * 16) * 256 + bj * 128) = pack8(acc[ai][bj][m][0] * rc[bj][0], acc[ai][bj][m][1] * rc[bj][1]);
        } else {
            const int h = u.pn & 3, b = u.pm >> 4;
            const float lg = __builtin_amdgcn_logf(1.0f - __builtin_amdgcn_exp2f(-5.0f - (float)h));
            float fi[2][4];
#pragma unroll
            for (int n = 0; n < 2; ++n)
#pragma unroll
                for (int j = 0; j < 4; ++j) fi[n][j] = __builtin_amdgcn_exp2f(-(float)(wc * 32 + 8 * fq + 4 * n + j) * RL) * I2PI;
            bf16_t* base = (u.ty == 0 ? QT : KTK) + (size_t)(b * 4 + h) * 4096 * 256 + wc * 32 + 8 * fq;
#pragma unroll
            for (int ai = 0; ai < 2; ++ai)
#pragma unroll
                for (int m = 0; m < 4; ++m) {
                    const int posi = (u.pm & 15) * 256 + ai * 128 + wr * 64 + m * 16 + fr, p = posi & 255; const float pos = (float)posi;
                    const float dec = ((u.ty == 0) ? __builtin_amdgcn_exp2f((float)p * lg) : 0.0625f * __builtin_amdgcn_exp2f(-(float)p * lg)) * RN[u.z * 256 + ai * 128 + wr * 64 + m * 16 + fr];
                    f32x4 y1[2], y2[2];
#pragma unroll
                    for (int n = 0; n < 2; ++n)
#pragma unroll
                        for (int j = 0; j < 4; ++j) {
                            const float rev = __builtin_amdgcn_fractf(pos * fi[n][j]); const float c = __builtin_amdgcn_cosf(rev), s = __builtin_amdgcn_sinf(rev);
                            const float x1 = acc[ai][0][m][n][j], x2 = acc[ai][1][m][n][j];
                            y1[n][j] = (x1 * c - x2 * s) * dec; y2[n][j] = (x1 * s + x2 * c) * dec; }
                    const u32x4 w1 = pack8(y1[0], y1[1]), w2 = pack8(y2[0], y2[1]);
                    *(u32x4*)(base + (size_t)posi * 256) = w1;
                    *(u32x4*)(base + (size_t)posi * 256 + 128) = w2;
                    if (u.ty == 1) {
                        PG8_LAS unsigned char* sc = tsc + (wr * 4 + wc) * 2048;
                        *(PG8_LAS u32x4*)(sc + fr * 64 + fq * 16) = w1; *(PG8_LAS u32x4*)(sc + 1024 + fr * 64 + fq * 16) = w2;
                        asm volatile("s_waitcnt lgkmcnt(0)" ::: "memory");
                        const int c = (fq & 1) * 16 + fr, o = fq >> 1; unsigned t1[4], t2[4];
#pragma unroll
                        for (int q = 0; q < 4; ++q) {
                            t1[q] = (unsigned)*(const PG8_LAS unsigned short*)(sc + (8 * o + 2 * q) * 64 + 2 * c) | ((unsigned)*(const PG8_LAS unsigned short*)(sc + (8 * o + 2 * q + 1) * 64 + 2 * c) << 16);
                            t2[q] = (unsigned)*(const PG8_LAS unsigned short*)(sc + 1024 + (8 * o + 2 * q) * 64 + 2 * c) | ((unsigned)*(const PG8_LAS unsigned short*)(sc + 1024 + (8 * o + 2 * q + 1) * 64 + 2 * c) << 16); }
                        bf16_t* kf = KF + ((size_t)(((b * 4 + h) * 16 + (u.pm & 15)) * 256 + wc * 32 + c)) * 256 + ai * 128 + wr * 64 + m * 16 + 8 * o;
                        *(u32x4*)kf = (u32x4){t1[0], t1[1], t1[2], t1[3]}; *(u32x4*)(kf + (size_t)128 * 256) = (u32x4){t2[0], t2[1], t2[2], t2[3]};
                        asm volatile("s_waitcnt lgkmcnt(0)" ::: "memory");
                    }
                    __builtin_amdgcn_sched_barrier(0);
                }
        }
    }
};
struct EpiMask {
    static constexpr bool PERM = true, KHOOK = false;
    bf16_t* P;
    __device__ __forceinline__ void operator()(f32x4 (&acc)[2][2][4][2], const Unit& u, int wr, int wc, int fr, int fq) const {
        asm volatile("" : "+v"(fr), "+v"(fq));
        bf16_t* base = P + ((size_t)u.z * 4096 + u.pm * 256 + wr * 64 + fr) * 256 + wc * 32 + 8 * fq;
#pragma unroll
        for (int ai = 0; ai < 2; ++ai)
#pragma unroll
            for (int m = 0; m < 4; ++m) { const int r = ai * 128 + wr * 64 + m * 16 + fr;
#pragma unroll
                for (int bj = 0; bj < 2; ++bj) { f32x4 v0 = acc[ai][bj][m][0], v1 = acc[ai][bj][m][1]; const int c0 = bj * 128 + wc * 32 + 8 * fq;
#pragma unroll
                    for (int j = 0; j < 4; ++j) { if (c0 + j > r) v0[j] = 0.f; if (c0 + 4 + j > r) v1[j] = 0.f; }
                    *(u32x4*)(base + (size_t)(ai * 128 + m * 16) * 256 + bj * 128) = pack8(v0, v1); } }
    }
};
struct EpiState {
    static constexpr bool PERM = true, KHOOK = false;
    bf16_t* ST;
    __device__ __forceinline__ void operator()(f32x4 (&acc)[2][2][4][2], const Unit& u, int wr, int wc, int fr, int fq) const {
        asm volatile("" : "+v"(fr), "+v"(fq));
        bf16_t* base = ST + ((size_t)u.z * 512 + u.pn * 256 + wr * 64 + fr) * 256 + wc * 32 + 8 * fq;
#pragma unroll
        for (int ai = 0; ai < 2; ++ai)
#pragma unroll
            for (int m = 0; m < 4; ++m)
#pragma unroll
                for (int bj = 0; bj < 2; ++bj) *(u32x4*)(base + (size_t)(ai * 128 + m * 16) * 256 + bj * 128) = pack8(acc[ai][bj][m][0], acc[ai][bj][m][1]);
    }
};
struct EpiMaskState {
    static constexpr bool PERM = true, KHOOK = false;
    EpiMask em; EpiState es;
    __device__ __forceinline__ void operator()(f32x4 (&acc)[2][2][4][2], const Unit& u, int wr, int wc, int fr, int fq) const { if (u.ty == 0) em(acc, u, wr, wc, fr, fq); else es(acc, u, wr, wc, fr, fq); }
};
struct EpiRetOut {
    static constexpr bool PERM = true, KHOOK = false;
    bf16_t* G; float* SS;
    __device__ __forceinline__ void operator()(f32x4 (&acc)[2][2][4][2], const Unit& u, int wr, int wc, int fr, int fq) const {
        asm volatile("" : "+v"(fr), "+v"(fq));
        const int h = u.z, half = u.pn;
        bf16_t* base = G + (size_t)(u.pm * 256 + wr * 64 + fr) * 2048 + h * 512 + half * 256 + wc * 32 + 8 * fq;
#pragma unroll
        for (int am = 0; am < 4; ++am) { const int ai = am >> 1;
            u32x4 gall[4][2];
#pragma unroll
            for (int m = 2 * (am & 1); m < 2 * (am & 1) + 2; ++m)
#pragma unroll
                for (int bj = 0; bj < 2; ++bj) gall[m][bj] = *(const u32x4*)(base + (size_t)(ai * 128 + m * 16) * 2048 + bj * 128);
            __builtin_amdgcn_sched_barrier(0);
#pragma unroll
            for (int m = 2 * (am & 1); m < 2 * (am & 1) + 2; ++m) {
                const int tok = u.pm * 256 + ai * 128 + wr * 64 + m * 16 + fr;
                float ss = 0.f;
#pragma unroll
                for (int bj = 0; bj < 2; ++bj)
#pragma unroll
                    for (int n = 0; n < 2; ++n) { const f32x4 x = acc[ai][bj][m][n]; ss += (x[0] * x[0] + x[1] * x[1]) + (x[2] * x[2] + x[3] * x[3]); }
                ss += __shfl_xor(ss, 16); ss += __shfl_xor(ss, 32);
                if (fq == 0) SS[((size_t)(tok * 4 + h) * 2 + half) * 4 + wc] = ss;
#pragma unroll
                for (int bj = 0; bj < 2; ++bj) {
                    bf16_t* p = base + (size_t)(ai * 128 + m * 16) * 2048 + bj * 128;
                    const u32x4 gw = gall[m][bj]; f32x4 v0 = acc[ai][bj][m][0], v1 = acc[ai][bj][m][1];
                    float gv[8] = {bflo(gw.x), bfhi(gw.x), bflo(gw.y), bfhi(gw.y), bflo(gw.z), bfhi(gw.z), bflo(gw.w), bfhi(gw.w)};
#pragma unroll
                    for (int j = 0; j < 4; ++j) { const float g0 = gv[j], g1 = gv[4 + j];
                        v0[j] *= g0 * __builtin_amdgcn_rcpf(1.0f + __builtin_amdgcn_exp2f(-g0 * 1.4426950408889634f));
                        v1[j] *= g1 * __builtin_amdgcn_rcpf(1.0f + __builtin_amdgcn_exp2f(-g1 * 1.4426950408889634f)); }
                    *(u32x4*)p = pack8(v0, v1); }
            }
        }
    }
};
#define PG8_RES_BODY(SCALE) \
        const size_t off0 = (size_t)(u.pm * 256 + wr * 64 + fr) * 1024 + u.pn * 256 + wc * 32 + 8 * fq; \
        _Pragma("unroll") for (int ai = 0; ai < 2; ++ai) { \
            u32x4 xw[4][2];     \
            _Pragma("unroll") for (int m = 0; m < 4; ++m) \
                _Pragma("unroll") for (int bj = 0; bj < 2; ++bj) xw[m][bj] = *(const u32x4*)(XB + off0 + (size_t)(ai * 128 + m * 16) * 1024 + bj * 128); \
            __builtin_amdgcn_sched_barrier(0); \
            _Pragma("unroll") for (int m = 0; m < 4; ++m) { const size_t off = off0 + (size_t)(ai * 128 + m * 16) * 1024; \
                float ss = 0.f; SCALE \
                _Pragma("unroll") for (int bj = 0; bj < 2; ++bj) { const u32x4 bw = xw[m][bj]; \
                    const f32x4 b0 = (f32x4){bflo(bw.x), bfhi(bw.x), bflo(bw.y), bfhi(bw.y)}, b1 = (f32x4){bflo(bw.z), bfhi(bw.z), bflo(bw.w), bfhi(bw.w)}; \
                    const f32x4 o0 = b0 + acc[ai][bj][m][0] * r3, o1 = b1 + acc[ai][bj][m][1] * r3; \
                    if (LAST) { *(f32x4*)(out + off + bj * 128) = o0; *(f32x4*)(out + off + bj * 128 + 4) = o1; } \
                    else { ss += ((o0[0] * o0[0] + o0[1] * o0[1]) + (o0[2] * o0[2] + o0[3] * o0[3])) + ((o1[0] * o1[0] + o1[1] * o1[1]) + (o1[2] * o1[2] + o1[3] * o1[3])); \
                        *(u32x4*)(XB + off + bj * 128) = pack8(o0, o1); } } \
                if (!LAST) { ss += __shfl_xor(ss, 16); ss += __shfl_xor(ss, 32); \
                    if (fq == 0) lsq[(ai * 128 + wr * 64 + m * 16 + fr) * 4 + wc] = ss; } \
                __builtin_amdgcn_sched_barrier(0); } } \
        if (!LAST) { asm volatile("s_waitcnt lgkmcnt(0)" ::: "memory"); __builtin_amdgcn_s_barrier(); asm volatile("" ::: "memory");     \
            const int t = (wr * 4 + wc) * 64 + fq * 16 + fr; if (t < 256) { const f32x4 p = *(const PG8_LAS f32x4*)(lsq + t * 4); SQ[(size_t)(u.pm * 256 + t) * 4 + u.pn] = (p[0] + p[1]) + (p[2] + p[3]); } }
template <bool LAST>
struct EpiRes {
    static constexpr bool PERM = true, KHOOK = false;
    bf16_t* XB; float* out; float* SQ; PG8_LAS float* lsq;
    __device__ __forceinline__ void operator()(f32x4 (&acc)[2][2][4][2], const Unit& u, int wr, int wc, int fr, int fq) const {
        asm volatile("" : "+v"(fr), "+v"(fq));
        PG8_RES_BODY(const float r3 = 1.0f;)
    }
};
struct EpiResH {
    static constexpr bool PERM = true, KHOOK = true, LAST = false;
    bf16_t* XB; float* out; float* SQ; PG8_LAS float* lsq; const PG8_LAS float* RAT;
    __device__ __forceinline__ void khook(f32x4 (&acc)[2][2][4][2], int hb, int wr, int) const {
        const int fr = lane_now() & 15;
#pragma unroll
        for (int ai = 0; ai < 2; ++ai)
#pragma unroll
            for (int m = 0; m < 4; ++m) { const float f = RAT[(hb - 1) * 256 + ai * 128 + wr * 64 + m * 16 + fr];
#pragma unroll
                for (int bj = 0; bj < 2; ++bj)
#pragma unroll
                    for (int n = 0; n < 2; ++n) acc[ai][bj][m][n] *= f;
                __builtin_amdgcn_sched_barrier(0); }
    }
    __device__ __forceinline__ void operator()(f32x4 (&acc)[2][2][4][2], const Unit& u, int wr, int wc, int fr, int fq) const {
        asm volatile("" : "+v"(fr), "+v"(fq));
        PG8_RES_BODY(const float r3 = RAT[3 * 256 + ai * 128 + wr * 64 + m * 16 + fr];)
    }
};
struct EpiUp {
    static constexpr bool PERM = true, KHOOK = false;
    bf16_t* U; const PG8_LAS float* R2;
    __device__ __forceinline__ void operator()(f32x4 (&acc)[2][2][4][2], const Unit& u, int wr, int wc, int fr, int fq) const {
        asm volatile("" : "+v"(fr), "+v"(fq));
        bf16_t* base = U + (size_t)(u.pm * 256 + wr * 64 + fr) * 4096 + u.pn * 256 + wc * 32 + 8 * fq;
#pragma unroll
        for (int ai = 0; ai < 2; ++ai)
#pragma unroll
            for (int m = 0; m < 4; ++m) {
                const float r2 = R2[u.z * 256 + ai * 128 + wr * 64 + m * 16 + fr];
#pragma unroll
                for (int bj = 0; bj < 2; ++bj) { f32x4 v0 = acc[ai][bj][m][0], v1 = acc[ai][bj][m][1];
#pragma unroll
                    for (int j = 0; j < 4; ++j) { const float a = __builtin_fmaxf(v0[j], 0.f), b = __builtin_fmaxf(v1[j], 0.f); v0[j] = a * a * r2; v1[j] = b * b * r2; }
                    *(u32x4*)(base + (size_t)(ai * 128 + m * 16) * 4096 + bj * 128) = pack8(v0, v1); } }
    }
};
template <bool MOBA>
struct EpiQKNorm {
    static constexpr bool PERM = true, KHOOK = false;
    bf16_t *Q, *K, *V; const float *qw, *kw; const PG8_LAS float* RN; bf16_t* KM; PG8_LAS float* cls;
    __device__ __forceinline__ void operator()(f32x4 (&acc)[2][2][4][2], const Unit& u, int wr, int wc, int fr, int fq) const {
        asm volatile("" : "+v"(fr), "+v"(fq));
        const int row0 = u.pm * 256 + wr * 64 + fr;
        float rnv[2][4];
#pragma unroll
        for (int ai = 0; ai < 2; ++ai)
#pragma unroll
            for (int m = 0; m < 4; ++m) rnv[ai][m] = RN[u.z * 256 + ai * 128 + wr * 64 + m * 16 + fr];
        if (u.pn >= 8) {
            bf16_t* base = V + (size_t)row0 * 1024 + (u.pn - 8) * 256 + wc * 32 + 8 * fq;
#pragma unroll
            for (int ai = 0; ai < 2; ++ai)
#pragma unroll
                for (int m = 0; m < 4; ++m) { const float rn = rnv[ai][m];
#pragma unroll
                    for (int bj = 0; bj < 2; ++bj) *(u32x4*)(base + (size_t)(ai * 128 + m * 16) * 1024 + bj * 128) = pack8(acc[ai][bj][m][0] * rn, acc[ai][bj][m][1] * rn); }
        } else {
            const bool isq = u.pn < 4; const float* w = isq ? qw : kw; const float sc = isq ? 0.125f * 1.4426950408889634f : 1.0f;
            f32x4 wv[2][2];
#pragma unroll
            for (int bj = 0; bj < 2; ++bj)
#pragma unroll
                for (int n = 0; n < 2; ++n) wv[bj][n] = *(const f32x4*)(w + 32 * bj + 8 * fq + 4 * n);
            bf16_t* base = (isq ? Q : K) + (size_t)row0 * 1024 + ((u.pn & 3) * 4 + wc) * 64 + 8 * fq;
#pragma unroll
            for (int ai = 0; ai < 2; ++ai)
#pragma unroll
                for (int m = 0; m < 4; ++m) {
                    float ss = 0.f; const float rn = rnv[ai][m];
#pragma unroll
                    for (int bj = 0; bj < 2; ++bj)
#pragma unroll
                        for (int n = 0; n < 2; ++n) { acc[ai][bj][m][n] *= rn; const f32x4 x = acc[ai][bj][m][n]; ss += (x[0] * x[0] + x[1] * x[1]) + (x[2] * x[2] + x[3] * x[3]); }
                    ss += __shfl_xor(ss, 16); ss += __shfl_xor(ss, 32);
                    const float r = __builtin_amdgcn_rsqf(ss * (1.0f / 64.0f) + 1e-6f) * sc;
#pragma unroll
                    for (int bj = 0; bj < 2; ++bj) { const f32x4 v0 = acc[ai][bj][m][0] * r * wv[bj][0], v1 = acc[ai][bj][m][1] * r * wv[bj][1];
                        *(u32x4*)(base + (size_t)(ai * 128 + m * 16) * 1024 + bj * 32) = pack8(v0, v1);
                        if constexpr (MOBA) { if (!isq) {
                            f32x4 s0 = v0, s1 = v1;
#pragma unroll
                            for (int j = 0; j < 4; ++j) { s0[j] = row16_sum(s0[j]); s1[j] = row16_sum(s1[j]); }
                            if (fr == 0) { PG8_LAS f32x4* p = (PG8_LAS f32x4*)(cls + (wr * 4 + wc) * 64 + bj * 32 + 8 * fq); p[0] = p[0] + s0; p[1] = p[1] + s1; } } } }
                }
            if constexpr (MOBA) { if (!isq) {
                asm volatile("s_waitcnt lgkmcnt(0)" ::: "memory"); __builtin_amdgcn_s_barrier(); asm volatile("" ::: "memory");
                const int t = (wr * 4 + wc) * 64 + fq * 16 + fr;
                if (t < 256) { const float sm = cls[t] + cls[256 + t];
                    KM[((size_t)((u.pm >> 4) * 64 + (u.pm & 15))) * 1024 + (u.pn & 3) * 256 + t] = (bf16_t)(cvt_pk_bf16(sm * (1.f / 256.f), 0.f) & 0xffffu);
                    cls[t] = 0.f; cls[256 + t] = 0.f; }
            } }
        }
    }
};

struct SchedPlain {
    const char* A; const char* Bt; int nM, nN, G, c; size_t ta, tb;
    __device__ __forceinline__ bool next(int i, Unit& u) const {
        const long L = (long)i * G + c; if (L >= (long)nM * nN) return false;
        int pm, pn; tile_of((int)L, nM, nN, pm, pn); u.pm = pm; u.pn = pn; u.ty = 0; u.z = i;
        u.a0 = A + (size_t)pm * ta; u.b0 = Bt + (size_t)pn * tb; u.a1 = u.a0; u.b1 = u.b0; return true;
    }
};
struct SchedRetIn {
    const char* H; const char* W; int G, c;
    __device__ __forceinline__ bool next(int i, Unit& u) const {
        const long L = (long)i * G + c; if (L >= 1536) return false;
        int pm, pn; u.z = i;
        if (L < 1024) { tile_of((int)L, 64, 16, pm, pn); u.ty = pn < 4 ? 0 : (pn < 8 ? 1 : 2);
            u.a0 = H + (size_t)pm * (256 * 1024 * 2); u.b0 = W + (size_t)(pn < 8 ? pn : pn + 8) * (256 * 1024 * 2); }
        else { tile_of((int)L - 1024, 8, 64, pm, pn); u.ty = 4;
            u.a0 = W + (size_t)(pm + 8) * (256 * 1024 * 2); u.b0 = H + (size_t)pn * (256 * 1024 * 2); }
        u.pm = pm; u.pn = pn; u.a1 = u.a0; u.b1 = u.b0; return true;
    }
};
struct SchedRetP {
    const char* QT; const char* KTK; int G, c;
    __device__ __forceinline__ bool next(int i, Unit& u) const {
        const long L = (long)i * G + c; if (L >= 256) return false;
        const int bh = (int)L >> 4, nc = (int)L & 15; u.z = bh; u.pm = nc; u.pn = 0; u.ty = 0;
        const size_t off = ((size_t)bh * 4096 + nc * 256) * 256 * 2; u.a0 = QT + off; u.b0 = KTK + off; u.a1 = u.a0; u.b1 = u.b0; return true;
    }
};
struct SchedRetPS {
    const char* QT; const char* KTK; const char* VT; const char* KF; int G, c;
    __device__ __forceinline__ bool next(int i, Unit& u) const {
        const long L = (long)i * G + c; if (L >= 768) return false;
        if (L < 256) { const int bh = (int)L >> 4, nc = (int)L & 15; u.z = bh; u.pm = nc; u.pn = 0; u.ty = 0;
            const size_t off = ((size_t)bh * 4096 + nc * 256) * 256 * 2; u.a0 = QT + off; u.b0 = KTK + off; }
        else { const int l2 = (int)L - 256, half = l2 & 1, nc = (l2 >> 1) & 15, bh = l2 >> 5; u.z = bh * 16 + nc; u.pn = half; u.pm = 0; u.ty = 1;
            u.a0 = VT + ((size_t)(bh * 16 + nc) * 512 + half * 256) * 256 * 2; u.b0 = KF + (size_t)(bh * 16 + nc) * 256 * 256 * 2; }
        u.a1 = u.a0; u.b1 = u.b0; return true;
    }
};
struct SchedRetO {
    const char* P; const char* QT; const char* VT; const char* ST; int G, c;
    __device__ __forceinline__ bool next(int i, Unit& u) const {
        const long L = (long)i * G + c; if (L >= 512) return false;
        const int half = (int)L & 1, nc = ((int)L >> 1) & 15, bh = (int)L >> 5;
        u.z = bh & 3; u.pn = half; u.pm = (bh >> 2) * 16 + nc; u.ty = 0;
        const size_t offa = ((size_t)bh * 4096 + nc * 256) * 256 * 2;
        u.a0 = P + offa; u.a1 = QT + offa;
        u.b0 = VT + ((size_t)(bh * 16 + nc) * 512 + half * 256) * 256 * 2; u.b1 = ST + ((size_t)(bh * 16 + nc) * 512 + half * 256) * 256 * 2; return true;
    }
};
}

namespace attn_body {
using bf16 = __hip_bfloat16;
using bf16x8 = __attribute__((ext_vector_type(8))) short;
using s16x4 = __attribute__((ext_vector_type(4))) short;
using f32x16 = __attribute__((ext_vector_type(16))) float;
using u32x4 = __attribute__((ext_vector_type(4))) unsigned;
constexpr int D = 64;
constexpr int NW = 8, QBLK = 32, QB = QBLK * NW, KVBLK = 64;
__device__ __forceinline__ int crow(int r, int hi) { return (r & 3) + 8 * (r >> 2) + 4 * hi; }
#define SBAR() __builtin_amdgcn_sched_barrier(0)
__device__ __forceinline__ void cmask(f32x16& p0, f32x16& p1, int jb, int qrel, int hi) {
  const float NEG = -INFINITY; int kb = 64 * jb + 4 * hi; asm volatile("" : "+v"(kb), "+v"(qrel));
  #pragma unroll
  for (int r = 0; r < 16; ++r) { int kv = kb + (r & 3) + 8 * (r >> 2); if (kv > qrel) p0[r] = NEG; if (kv + 32 > qrel) p1[r] = NEG; }
}
constexpr int NSLOT = 3, SLOTB = 8192;
constexpr int LDS_K = 0, LDS_V = NSLOT * SLOTB, LDS_WS = 2 * NSLOT * SLOTB, LDS_OST = LDS_WS + NW * 64 * 4, LDS_BYTES = LDS_OST + NW * 4096;
constexpr int LDS_TAB = 86016, TAB_N = 4096 + 256;
__device__ __forceinline__ void glds16(const void* gsrc, unsigned lds_dst) { unsigned keep;
  asm volatile("s_mov_b32 %0, m0\n\ts_mov_b32 m0, %2\n\ts_nop 0\n\tglobal_load_lds_dwordx4 %1, off\n\ts_mov_b32 m0, %0" : "=&s"(keep) : "v"(gsrc), "s"(lds_dst) : "memory"); }
__device__ __forceinline__ void glds16s(const void* sbase, unsigned voff, unsigned lds_dst) { unsigned keep;
  asm volatile("s_mov_b32 %0, m0\n\ts_mov_b32 m0, %3\n\ts_nop 4\n\tglobal_load_lds_dwordx4 %1, %2\n\ts_mov_b32 m0, %0" : "=&s"(keep) : "v"(voff), "s"(sbase), "s"(lds_dst) : "memory"); }
__device__ __forceinline__ float max3f(float a, float b, float c) { float r; asm("v_max3_f32 %0, %1, %2, %3" : "=v"(r) : "v"(a), "v"(b), "v"(c)); return r; }
__device__ __forceinline__ float max2f(float a, float b) { float r; asm("v_max_f32_e32 %0, %1, %2" : "=v"(r) : "v"(a), "v"(b)); return r; }
__device__ __forceinline__ float fadd_s(float a, float b) { float r; asm("v_add_f32_e32 %0, %1, %2" : "=v"(r) : "v"(a), "v"(b)); return r; }
__device__ __forceinline__ float fsub_s(float a, float b) { float r; asm("v_sub_f32_e32 %0, %1, %2" : "=v"(r) : "v"(a), "v"(b)); return r; }
typedef float f32x2_t __attribute__((ext_vector_type(2))); typedef __bf16 bf16x2_t __attribute__((ext_vector_type(2)));
__device__ __forceinline__ unsigned cvtpk_s(float lo, float hi) { f32x2_t v = {lo, hi}; bf16x2_t b = __builtin_convertvector(v, bf16x2_t); return __builtin_bit_cast(unsigned, b); }
#define WAIT_BAR(N) asm volatile("s_waitcnt vmcnt(" #N ") lgkmcnt(0)\n\ts_barrier" ::: "memory")

__device__ __forceinline__ void qkt(f32x16& p0, f32x16& p1, const char* Kslot, const bf16x8* qr, const f32x16& negm, int r32, int hi) {
  const char* kb = Kslot + hi * 1024 + r32 * 16;
  #pragma unroll
  for (int d0 = 0; d0 < 4; ++d0) {
    const bf16x8 b0 = *reinterpret_cast<const bf16x8*>(kb + d0 * 2048);
    const bf16x8 b1 = *reinterpret_cast<const bf16x8*>(kb + d0 * 2048 + 512);
    if (d0 == 0) { p0 = __builtin_amdgcn_mfma_f32_32x32x16_bf16(b0, qr[0], negm, 0, 0, 0); p1 = __builtin_amdgcn_mfma_f32_32x32x16_bf16(b1, qr[0], negm, 0, 0, 0); }
    else { p0 = __builtin_amdgcn_mfma_f32_32x32x16_bf16(b0, qr[d0], p0, 0, 0, 0); p1 = __builtin_amdgcn_mfma_f32_32x32x16_bf16(b1, qr[d0], p1, 0, 0, 0); } }
}
typedef __attribute__((address_space(3))) const char* lds_cptr;
typedef __attribute__((address_space(3))) const float* lds_fptr;
typedef short v4i16_t __attribute__((ext_vector_type(4)));
__device__ __forceinline__ void kload8(bf16x8* kf, lds_cptr kp) {
  kf[0] = *(const __attribute__((address_space(3))) bf16x8*)(kp);        kf[1] = *(const __attribute__((address_space(3))) bf16x8*)(kp + 512);
  kf[2] = *(const __attribute__((address_space(3))) bf16x8*)(kp + 2048); kf[3] = *(const __attribute__((address_space(3))) bf16x8*)(kp + 2560);
  kf[4] = *(const __attribute__((address_space(3))) bf16x8*)(kp + 4096); kf[5] = *(const __attribute__((address_space(3))) bf16x8*)(kp + 4608);
  kf[6] = *(const __attribute__((address_space(3))) bf16x8*)(kp + 6144); kf[7] = *(const __attribute__((address_space(3))) bf16x8*)(kp + 6656);
}
__device__ __forceinline__ void kload2(bf16x8* kf, lds_cptr kp, int j) { kf[2 * j] = *(const __attribute__((address_space(3))) bf16x8*)(kp + j * 2048); kf[2 * j + 1] = *(const __attribute__((address_space(3))) bf16x8*)(kp + j * 2048 + 512); }
__device__ __forceinline__ s16x4 vtr(lds_cptr p) { return __builtin_bit_cast(s16x4, __builtin_amdgcn_ds_read_tr16_b64_v4i16((__attribute__((address_space(3))) v4i16_t*)p)); }
__device__ __forceinline__ float rowmax(const f32x16& p0, const f32x16& p1) {
  float a = max3f(p0[0], p0[1], p1[0]), b = max3f(p0[2], p0[3], p1[1]); a = max3f(a, p1[2], p1[3]);
  #pragma unroll
  for (int r = 4; r < 16; r += 4) { a = max3f(a, p0[r], p0[r + 1]); b = max3f(b, p0[r + 2], p0[r + 3]); a = max3f(a, p1[r], p1[r + 1]); b = max3f(b, p1[r + 2], p1[r + 3]); }
  const float m = max2f(a, b);
  auto rr = __builtin_amdgcn_permlane32_swap(__float_as_uint(m), __float_as_uint(m), false, false);
  return max2f(__uint_as_float(rr[0]), __uint_as_float(rr[1]));
}
__device__ __forceinline__ void pv(f32x16* o, int vb, bf16x8 pa0, bf16x8 pa1, bf16x8 pa2, bf16x8 pa3) {
  #pragma unroll
  for (int d0 = 0; d0 < 2; ++d0) { s16x4 lo[4], hi[4];
    #pragma unroll
    for (int ks = 0; ks < 4; ++ks) {
      asm volatile("ds_read_b64_tr_b16 %0,%1 offset:%c2" : "=&v"(lo[ks]) : "v"(vb), "i"(d0 * 4096 + ks * 1024) : "memory");
      asm volatile("ds_read_b64_tr_b16 %0,%1 offset:%c2" : "=&v"(hi[ks]) : "v"(vb), "i"(d0 * 4096 + ks * 1024 + 512) : "memory"); }
    asm volatile("s_waitcnt lgkmcnt(0)" ::: "memory"); SBAR();
    #define PK(k) (bf16x8){lo[k][0], lo[k][1], lo[k][2], lo[k][3], hi[k][0], hi[k][1], hi[k][2], hi[k][3]}
    o[d0] = __builtin_amdgcn_mfma_f32_32x32x16_bf16(pa0, PK(0), o[d0], 0, 0, 0);
    o[d0] = __builtin_amdgcn_mfma_f32_32x32x16_bf16(pa1, PK(1), o[d0], 0, 0, 0);
    o[d0] = __builtin_amdgcn_mfma_f32_32x32x16_bf16(pa2, PK(2), o[d0], 0, 0, 0);
    o[d0] = __builtin_amdgcn_mfma_f32_32x32x16_bf16(pa3, PK(3), o[d0], 0, 0, 0);
    #undef PK
  }
}
template <int GSZ> __device__ __forceinline__ void addbias(f32x16& p0, f32x16& p1, lds_fptr tab, int dq) {
  const lds_fptr tp = tab + (dq + 256 - 64);
  asm volatile("s_waitcnt lgkmcnt(0)" ::: "memory");
  #pragma unroll
  for (int g = 0; g < 16 / GSZ; ++g) {
    float a0[GSZ], a1[GSZ];
    #pragma unroll
    for (int i = 0; i < GSZ; ++i) { const int r = GSZ * g + i, off = (r & 3) + 8 * (r >> 2); a0[i] = tp[64 - off]; a1[i] = tp[32 - off]; }
    asm volatile("s_waitcnt lgkmcnt(0)" ::: "memory");
    #pragma unroll
    for (int i = 0; i < GSZ; ++i) { const int r = GSZ * g + i; p0[r] = fadd_s(p0[r], a0[i]); p1[r] = fadd_s(p1[r], a1[i]); }
    SBAR(); }
}

__device__ __forceinline__ void addbias_far(f32x16& p0, f32x16& p1, float subc) {
  #pragma unroll
  for (int r = 0; r < 16; ++r) { p0[r] = fsub_s(p0[r], subc); p1[r] = fsub_s(p1[r], subc); }
}
#define ATTN_STORE16(p, v) (*(u32x4*)(p) = (v))
template<int MODE, int THRL, int OP> __device__ __forceinline__ void attn_unit(int b, int qb, const bf16* Q, int qc, const bf16* __restrict__ K, int kc, const bf16* __restrict__ V, int vc,
                                                                      bf16* O, int oc, const bf16* KM, char* shm, const int wid) {
  constexpr int qp = 1024, kp = 1024, vp = 1024, op = OP, kmp = 1024;
  const int lane = lane_now(), r32 = lane & 31, hi = lane >> 5;
  const long rowbase = (long)b * SEQ; const int q0 = qb * QB;
  const bf16* Qw = Q + (rowbase + q0 + wid * QBLK) * qp + qc;
  const bf16* Kh = K + rowbase * kp + kc, *Vh = V + rowbase * vp + vc;
  const unsigned lds0 = (unsigned)(uintptr_t)shm;
  float* wsf = (float*)(shm + LDS_WS) + wid * 64;
  const lds_fptr tab = (lds_fptr)(lds_cptr)shm + LDS_TAB / 4;
  const unsigned koff = (unsigned)(lane * kp + wid * 8) * 2u;
  const unsigned voff = (unsigned)((16 * (wid & 3) + (lane >> 2)) * vp + (wid >> 2) * 32 + (lane & 3) * 8) * 2u;
  const unsigned kdst = lds0 + LDS_K + wid * 1024, vdst = lds0 + LDS_V + wid * 1024;
  #define DMA_K(t, slot) glds16s(Kh + (long)(t) * KVBLK * kp, koff, (unsigned)__builtin_amdgcn_readfirstlane(kdst + (slot)))
  #define DMA_V(t, slot) glds16s(Vh + (long)(t) * KVBLK * vp, voff, (unsigned)__builtin_amdgcn_readfirstlane(vdst + (slot)))
  const int vb0 = (int)(lds0 + LDS_V) + ((lane >> 4) & 1) * 32 + (lane & 3) * 8 + (4 * hi + ((lane & 15) >> 2)) * 64;
  const char* Kbase = shm + LDS_K; bf16x8 kf[8];
  const lds_cptr shm3 = (lds_cptr)shm; const lds_cptr kp0 = shm3 + LDS_K + hi * 1024 + r32 * 16; const lds_cptr vp0 = shm3 + LDS_V + ((lane >> 4) & 1) * 32 + (lane & 3) * 8 + (4 * hi + ((lane & 15) >> 2)) * 64;
  const int NT = (q0 + QB) / KVBLK;
  bf16x8 qr[4];
  #pragma unroll
  for (int d0 = 0; d0 < 4; ++d0) qr[d0] = *reinterpret_cast<const bf16x8*>(&Qw[(long)r32 * qp + d0 * 16 + hi * 8]);
  unsigned selmask = 0xffffffffu;
  if constexpr (MODE == 1) {
    glds16s(KM, (unsigned)(lane * kmp + wid * 8) * 2u, (unsigned)__builtin_amdgcn_readfirstlane(kdst));
    WAIT_BAR(0);
    f32x16 g0, g1; { const f32x16 z = f32x16{}; qkt(g0, g1, Kbase, qr, z, r32, hi); }
    asm volatile("s_nop 15\n\ts_nop 7" : "+v"(g0), "+v"(g1));
    float gg[16];
    #pragma unroll
    for (int r = 0; r < 8; ++r) { const float own = g0[r], oth = __shfl_xor(own, 32); const float lo = hi ? oth : own, hh = hi ? own : oth;
      gg[(r & 3) + 8 * (r >> 2)] = lo; gg[4 + (r & 3) + 8 * (r >> 2)] = hh; }
    #pragma unroll
    for (int n = 0; n < 16; ++n) gg[n] = (n < qb) ? gg[n] : -INFINITY;
    selmask = 0u;
    #pragma unroll
    for (int n = 0; n < 16; ++n) { int cnt = 0;
      #pragma unroll
      for (int m2 = 0; m2 < 16; ++m2) { if (m2 == n) continue; cnt += (gg[m2] > gg[n] || (gg[m2] == gg[n] && m2 < n)) ? 1 : 0; }
      const unsigned bit = (n < qb && cnt < 3) ? 1u : 0u; selmask |= bit << n; }
    asm volatile("s_waitcnt lgkmcnt(0)\n\ts_barrier" ::: "memory");
  }
  DMA_K(0, 0); DMA_V(0, 0); DMA_K(1, SLOTB);
  float mhat = 0.f, l_reg = 0.f; f32x16 o[2]; o[0] = f32x16{}; o[1] = f32x16{}; f32x16 negm = f32x16{}; asm volatile("" : "+v"(negm));
  const int qrel = wid * QBLK + r32;
  const int dq0 = q0 + qrel - 4 * hi;
  #define CMASK(P0, P1, t) do { int jb_ = (t) - (NT - 4); if (jb_ >= 0) cmask(P0, P1, jb_, qrel, hi); } while (0)
  #define BIAS(P0, P1, t) do { \
      if (MODE == 1) { if ((t) < NT - 4) { if (!((selmask >> ((t) >> 2)) & 1u)) { _Pragma("unroll") for (int r = 0; r < 16; ++r) { P0[r] = fsub_s(P0[r], 4096.f); P1[r] = fsub_s(P1[r], 4096.f); } } } } \
      if (64 * (t) + 853 > q0 + wid * QBLK) addbias<8>(P0, P1, tab, dq0 - 64 * (t)); } while (0)
  bool resc = false;
  #define START(P0, P1) do { const float rm = rowmax(P0, P1); resc = false; \
    { const float dl = rm; mhat = fadd_s(mhat, dl); \
      _Pragma("unroll") for (int r = 0; r < 16; ++r) { P0[r] = fsub_s(P0[r], dl); P1[r] = fsub_s(P1[r], dl); } \
      _Pragma("unroll") for (int r = 0; r < 16; ++r) negm[r] = -mhat; asm volatile("" : "+v"(negm)); } \
    _Pragma("unroll") for (int r = 0; r < 16; ++r) P0[r] = __builtin_amdgcn_exp2f(P0[r]); } while (0)
  #define RESC() do { if (resc) { asm volatile("s_waitcnt lgkmcnt(0)" ::: "memory"); \
      _Pragma("unroll") for (int d_ = 0; d_ < 2; ++d_) _Pragma("unroll") for (int r = 0; r < 16; ++r) o[d_][r] *= wsf[crow(r, hi)]; } } while (0)
  f32x16 pA0, pA1, pB0, pB1;
  int sl_prev = 0, sl_cur = 0, sl_next = SLOTB;
  #define ROT() do { sl_prev = sl_cur; sl_cur = sl_next; sl_next = (sl_next == (NSLOT - 1) * SLOTB) ? 0 : sl_next + SLOTB; } while (0)
  DMA_K(2, 2 * SLOTB);
  WAIT_BAR(3);
  qkt(pA0, pA1, Kbase, qr, negm, r32, hi); asm volatile("s_nop 15\n\ts_nop 7" : "+v"(pA0), "+v"(pA1)); BIAS(pA0, pA1, 0); CMASK(pA0, pA1, 0);
  START(pA0, pA1);
  _Pragma("unroll") for (int r = 0; r < 16; ++r) pA1[r] = __builtin_amdgcn_exp2f(pA1[r]);
  WAIT_BAR(0);
  DMA_K(3, 0); DMA_V(1, SLOTB);
  ROT();
  kload8(kf, kp0 + sl_cur);
  WAIT_BAR(2);
  s16x4 vlo[8], vhi[8]; u32x4 pw0, pw1, pw2, pw3;
  #define PKW(P, B) cvtpk_s(P[B], P[B + 1])
  #define PAF(k) __builtin_bit_cast(bf16x8, pw##k)
  #define VFR(i) (bf16x8){vlo[i][0], vlo[i][1], vlo[i][2], vlo[i][3], vhi[i][0], vhi[i][1], vhi[i][2], vhi[i][3]}
  #define PIN(x) asm volatile("" : "+v"(x))
  #define MX3(a, b, c) __builtin_fmaxf(__builtin_fmaxf((a), (b)), (c))
  #define GAPA(MF, A0, A1, A2, A3, W0, W1, PW) do { MF; sacc += A0; sacc += A1; sacc += A2; sacc += A3; PIN(sacc); W0; W1; PIN(PW); SBAR(); } while (0)
  #define EX(v) __builtin_amdgcn_exp2f(v)
  #define GAPB(MF, X, B) do { MF; X[B] = EX(X[B]); X[B + 1] = EX(X[B + 1]); X[B + 2] = EX(X[B + 2]); X[B + 3] = EX(X[B + 3]); PIN(X); SBAR(); } while (0)
  #define VRD(i) do { vlo[i] = vtr(vp_ + (((i) >> 2) * 4096 + ((i) & 3) * 1024)); vhi[i] = vtr(vp_ + (((i) >> 2) * 4096 + ((i) & 3) * 1024 + 512)); } while (0)
  #define KRD(G, j) do { if (G) { kload2(kf, kp0 + sl_next, j); SBAR(); } } while (0)
  #define STEP(C0, C1, P0, P1, t, GK, GV, GL) do { SBAR(); \
    const lds_cptr vp_ = vp0 + sl_prev; \
    VRD(0); SBAR(); float sacc = (P0[0] + P0[1]); \
    GAPA(C0 = __builtin_amdgcn_mfma_f32_32x32x16_bf16(kf[0], qr[0], negm, 0, 0, 0), P0[2], P0[3], P0[4], P0[5],     pw0[0] = PKW(P0, 0), pw0[1] = PKW(P0, 2), pw0); \
    VRD(4); SBAR(); GAPA(C1 = __builtin_amdgcn_mfma_f32_32x32x16_bf16(kf[1], qr[0], negm, 0, 0, 0), P0[6], P0[7], P0[8], P0[9],     pw0[2] = PKW(P0, 4), pw0[3] = PKW(P0, 6), pw0); \
    VRD(1); SBAR(); GAPA(C0 = __builtin_amdgcn_mfma_f32_32x32x16_bf16(kf[2], qr[1], C0, 0, 0, 0),   P0[10], P0[11], P0[12], P0[13], pw1[0] = PKW(P0, 8), pw1[1] = PKW(P0, 10), pw1); \
    VRD(5); SBAR(); GAPA(C1 = __builtin_amdgcn_mfma_f32_32x32x16_bf16(kf[3], qr[1], C1, 0, 0, 0),   P0[14], P0[15], P1[0], P1[1],   pw1[2] = PKW(P0, 12), pw1[3] = PKW(P0, 14), pw1); \
    VRD(2); SBAR(); GAPA(C0 = __builtin_amdgcn_mfma_f32_32x32x16_bf16(kf[4], qr[2], C0, 0, 0, 0),   P1[2], P1[3], P1[4], P1[5],     pw2[0] = PKW(P1, 0), pw2[1] = PKW(P1, 2), pw2); \
    VRD(6); SBAR(); GAPA(C1 = __builtin_amdgcn_mfma_f32_32x32x16_bf16(kf[5], qr[2], C1, 0, 0, 0),   P1[6], P1[7], P1[8], P1[9],     pw2[2] = PKW(P1, 4), pw2[3] = PKW(P1, 6), pw2); \
    VRD(3); SBAR(); GAPA(C0 = __builtin_amdgcn_mfma_f32_32x32x16_bf16(kf[6], qr[3], C0, 0, 0, 0),   P1[10], P1[11], P1[12], P1[13], pw3[0] = PKW(P1, 8), pw3[1] = PKW(P1, 10), pw3); \
    VRD(7); SBAR(); GAPA(C1 = __builtin_amdgcn_mfma_f32_32x32x16_bf16(kf[7], qr[3], C1, 0, 0, 0),   P1[14], P1[15], 0.f, 0.f,       pw3[2] = PKW(P1, 12), pw3[3] = PKW(P1, 14), pw3); \
    l_reg += sacc; \
    if (GK) { DMA_K((t) + 3, sl_cur); } if (GV) { DMA_V((t) + 1, sl_next); } \
    asm volatile("s_nop 15\n\ts_nop 3" : "+v"(C0), "+v"(C1)); BIAS(C0, C1, t); \
    CMASK(C0, C1, t); \
    { float a = MX3(C0[0], C0[1], C1[0]), b = MX3(C0[2], C0[3], C1[1]); a = MX3(a, C1[2], C1[3]); \
      _Pragma("unroll") for (int r = 4; r < 16; r += 4) { a = MX3(a, C0[r], C0[r + 1]); b = MX3(b, C0[r + 2], C0[r + 3]); a = MX3(a, C1[r], C1[r + 1]); b = MX3(b, C1[r + 2], C1[r + 3]); } \
      float rm = __builtin_fmaxf(a, b); { auto rr = __builtin_amdgcn_permlane32_swap(__float_as_uint(rm), __float_as_uint(rm), false, false); rm = __builtin_fmaxf(__uint_as_float(rr[0]), __uint_as_float(rr[1])); } \
      resc = false; \
      if (__builtin_expect(__any(rm > (float)THRL), 0)) { const float dl = __builtin_fmaxf(rm, 0.f); mhat += dl; \
        _Pragma("unroll") for (int r = 0; r < 16; ++r) { C0[r] -= dl; C1[r] -= dl; } \
        _Pragma("unroll") for (int r = 0; r < 16; ++r) negm[r] = -mhat; asm volatile("" : "+v"(negm)); \
        const float f = __builtin_amdgcn_exp2f(-dl); l_reg *= f; if (hi == 0) wsf[r32] = f; resc = true; } } \
    SBAR(); \
    GAPB(o[0] = __builtin_amdgcn_mfma_f32_32x32x16_bf16(PAF(0), VFR(0), o[0], 0, 0, 0), C0, 0); \
    GAPB(o[1] = __builtin_amdgcn_mfma_f32_32x32x16_bf16(PAF(0), VFR(4), o[1], 0, 0, 0), C0, 4); \
    KRD(GL, 0); GAPB(o[0] = __builtin_amdgcn_mfma_f32_32x32x16_bf16(PAF(1), VFR(1), o[0], 0, 0, 0), C0, 8); \
    KRD(GL, 1); GAPB(o[1] = __builtin_amdgcn_mfma_f32_32x32x16_bf16(PAF(1), VFR(5), o[1], 0, 0, 0), C0, 12); \
    KRD(GL, 2); GAPB(o[0] = __builtin_amdgcn_mfma_f32_32x32x16_bf16(PAF(2), VFR(2), o[0], 0, 0, 0), C1, 0); \
    KRD(GL, 3); GAPB(o[1] = __builtin_amdgcn_mfma_f32_32x32x16_bf16(PAF(2), VFR(6), o[1], 0, 0, 0), C1, 4); \
    GAPB(o[0] = __builtin_amdgcn_mfma_f32_32x32x16_bf16(PAF(3), VFR(3), o[0], 0, 0, 0), C1, 8); \
    GAPB(o[1] = __builtin_amdgcn_mfma_f32_32x32x16_bf16(PAF(3), VFR(7), o[1], 0, 0, 0), C1, 12); \
    } while (0)
  int t = 1;
  #undef CMASK
  #define CMASK(P0, P1, t) do {} while (0)
  for (; t + 5 < NT; t += 2) {
    STEP(pB0, pB1, pA0, pA1, t, true, true, true);     WAIT_BAR(2); RESC(); ROT();
    STEP(pA0, pA1, pB0, pB1, t + 1, true, true, true); WAIT_BAR(2); RESC(); ROT();
  }
  #undef CMASK
  #define CMASK(P0, P1, t) do { int jb_ = (t) - (NT - 4); if (jb_ >= 0) cmask(P0, P1, jb_, qrel, hi); } while (0)
  #define ENDW(tt) do { if ((tt) + 3 < NT) { WAIT_BAR(2); } else if ((tt) + 2 < NT) { WAIT_BAR(1); } else { WAIT_BAR(0); } } while (0)
  for (; t + 1 < NT; t += 2) {
    STEP(pB0, pB1, pA0, pA1, t, (t + 3 < NT), (t + 1 < NT), (t + 1 < NT));     ENDW(t);     RESC(); ROT();
    STEP(pA0, pA1, pB0, pB1, t + 1, (t + 4 < NT), (t + 2 < NT), (t + 2 < NT)); ENDW(t + 1); RESC(); ROT();
  }
  STEP(pB0, pB1, pA0, pA1, NT - 1, false, false, false); RESC();
  { float sacc = pB0[0] + pB0[1]; _Pragma("unroll") for (int r = 2; r < 16; ++r) sacc += pB0[r]; _Pragma("unroll") for (int r = 0; r < 16; ++r) sacc += pB1[r]; l_reg += sacc;
    pw0 = (u32x4){PKW(pB0, 0), PKW(pB0, 2), PKW(pB0, 4), PKW(pB0, 6)}; pw1 = (u32x4){PKW(pB0, 8), PKW(pB0, 10), PKW(pB0, 12), PKW(pB0, 14)}; pw2 = (u32x4){PKW(pB1, 0), PKW(pB1, 2), PKW(pB1, 4), PKW(pB1, 6)}; pw3 = (u32x4){PKW(pB1, 8), PKW(pB1, 10), PKW(pB1, 12), PKW(pB1, 14)};
    SBAR(); pv(o, vb0 + sl_cur, PAF(0), PAF(1), PAF(2), PAF(3)); }
  #undef PKW
  #undef PAF
  #undef VFR
  #undef PIN
  #undef MX3
  #undef GAPA
  #undef GAPB
  #undef EX
  #undef VRD
  #undef KRD
  #undef STEP
  #undef ENDW
  { auto rr = __builtin_amdgcn_permlane32_swap(__float_as_uint(l_reg), __float_as_uint(l_reg), false, false); l_reg = __uint_as_float(rr[0]) + __uint_as_float(rr[1]); }
  if (hi == 0) wsf[32 + r32] = l_reg; asm volatile("s_waitcnt lgkmcnt(0)" ::: "memory");
  float rli[16];
  #pragma unroll
  for (int r = 0; r < 16; ++r) rli[r] = __builtin_amdgcn_rcpf(wsf[32 + crow(r, hi)]);
  bf16* Ow = O + (rowbase + q0 + wid * QBLK) * op + oc;
  { bf16* stg = (bf16*)(shm + LDS_OST) + wid * 2048;
    #pragma unroll
    for (int r = 0; r < 16; ++r) { const int orow = crow(r, hi);
      #pragma unroll
      for (int d0 = 0; d0 < 2; ++d0) stg[orow * 64 + d0 * 32 + r32] = __float2bfloat16(o[d0][r] * rli[r]); }
    asm volatile("s_waitcnt lgkmcnt(0)" ::: "memory");
    #pragma unroll
    for (int i = 0; i < 4; ++i) { const int row = i * 8 + (lane >> 3), ch = lane & 7; const u32x4 v = *(const u32x4*)(stg + row * 64 + ch * 8); ATTN_STORE16(Ow + (long)row * op + ch * 8, v); } }
  asm volatile("s_waitcnt lgkmcnt(0)\n\ts_barrier" ::: "memory");
  #undef DMA_K
  #undef DMA_V
  #undef CMASK
  #undef BIAS
  #undef START
  #undef RESC
  #undef ROT
}
constexpr int V2_K = 0, V2_V = 24576, V2_WS = 73728, V2_Q = 75776, V2_TAB = 110592;
template<int THRL> __device__ __forceinline__ void attn_unit_v128(int b, int qb, const bf16* Q, int qc, const bf16* __restrict__ K, int kc, const bf16* __restrict__ V, int vc,
                                                                 bf16* O, int oc, char* shm, const int wid) {
  constexpr int MODE = 0; constexpr int qp = 1024, kp = 1024, vp = 1024, op = 2048;
  const int lane = lane_now(), r32 = lane & 31, hi = lane >> 5;
  const long rowbase = (long)b * SEQ; const int q0 = qb * QB;
  const bf16* Qw = Q + (rowbase + q0 + wid * QBLK) * qp + qc;
  const bf16* Kh = K + rowbase * kp + kc, *Vh = V + rowbase * vp + vc;
  const unsigned lds0 = (unsigned)(uintptr_t)shm;
  float* wsf = (float*)(shm + V2_WS) + wid * 64;
  const lds_fptr tab = (lds_fptr)(lds_cptr)shm + V2_TAB / 4;
  const unsigned koff = (unsigned)(lane * kp + wid * 8) * 2u;
  const unsigned voff = (unsigned)((16 * (wid & 3) + (lane >> 2)) * vp + (wid >> 2) * 32 + (lane & 3) * 8) * 2u;
  const unsigned kdst = lds0 + V2_K + wid * 1024, vdst = lds0 + V2_V + wid * 1024;
  #define DMA_K(t, slot) glds16s(Kh + (long)(t) * KVBLK * kp, koff, (unsigned)__builtin_amdgcn_readfirstlane(kdst + (slot)))
  #define DMA_V(t, slot) do { glds16s(Vh + (long)(t) * KVBLK * vp, voff, (unsigned)__builtin_amdgcn_readfirstlane(vdst + 2 * (slot))); glds16s(Vh + (long)(t) * KVBLK * vp, voff + 128u, (unsigned)__builtin_amdgcn_readfirstlane(vdst + 2 * (slot) + 8192)); } while (0)
  const int vb0 = (int)(lds0 + V2_V) + ((lane >> 4) & 1) * 32 + (lane & 3) * 8 + (4 * hi + ((lane & 15) >> 2)) * 64;
  const char* Kbase = shm + V2_K; bf16x8 kf[8];
  const lds_cptr shm3 = (lds_cptr)shm; const lds_cptr kp0 = shm3 + V2_K + hi * 1024 + r32 * 16; const lds_cptr vp0 = shm3 + V2_V + ((lane >> 4) & 1) * 32 + (lane & 3) * 8 + (4 * hi + ((lane & 15) >> 2)) * 64;
  const int NT = (q0 + QB) / KVBLK;
  bf16x8 qr[4];
  #pragma unroll
  for (int d0 = 0; d0 < 4; ++d0) qr[d0] = *reinterpret_cast<const bf16x8*>(&Qw[(long)r32 * qp + d0 * 16 + hi * 8]);
  typedef __attribute__((address_space(3))) bf16x8* lds_qptr; const lds_qptr qlds = (lds_qptr)(shm3 + V2_Q + wid * 4096 + lane * 16);
  DMA_K(0, 0); DMA_V(0, 0); DMA_K(1, SLOTB);
  float mhat = 0.f, l_reg = 0.f; f32x16 o[4]; o[0] = f32x16{}; o[1] = f32x16{}; o[2] = f32x16{}; o[3] = f32x16{}; const f32x16 negm = f32x16{};
  const int qrel = wid * QBLK + r32;
  const int dq0 = q0 + qrel - 4 * hi;
  #define CMASK(P0, P1, t) do { int jb_ = (t) - (NT - 4); if (jb_ >= 0) cmask(P0, P1, jb_, qrel, hi); } while (0)
  #define BIAS(P0, P1, t) do { if (64 * (t) + 853 > q0 + wid * QBLK) addbias<8>(P0, P1, tab, dq0 - 64 * (t)); addbias_far(P0, P1, mhat); } while (0)
  bool resc = false;
  #define START(P0, P1) do { const float rm = rowmax(P0, P1); resc = false; \
    { const float dl = rm; mhat = fadd_s(mhat, dl); \
      _Pragma("unroll") for (int r = 0; r < 16; ++r) { P0[r] = fsub_s(P0[r], dl); P1[r] = fsub_s(P1[r], dl); } \
      } \
    _Pragma("unroll") for (int r = 0; r < 16; ++r) P0[r] = __builtin_amdgcn_exp2f(P0[r]); } while (0)
  #define RESC() do { if (resc) { asm volatile("s_waitcnt lgkmcnt(0)" ::: "memory"); \
      _Pragma("unroll") for (int d_ = 0; d_ < 4; ++d_) _Pragma("unroll") for (int r = 0; r < 16; ++r) o[d_][r] *= wsf[crow(r, hi)]; } } while (0)
  f32x16 pA0, pA1, pB0, pB1;
  int sl_prev = 0, sl_cur = 0, sl_next = SLOTB;
  #define ROT() do { sl_prev = sl_cur; sl_cur = sl_next; sl_next = (sl_next == (NSLOT - 1) * SLOTB) ? 0 : sl_next + SLOTB; } while (0)
  DMA_K(2, 2 * SLOTB);
  WAIT_BAR(4);
  qkt(pA0, pA1, Kbase, qr, negm, r32, hi); asm volatile("s_nop 15\n\ts_nop 7" : "+v"(pA0), "+v"(pA1)); BIAS(pA0, pA1, 0); CMASK(pA0, pA1, 0);
  START(pA0, pA1);
  _Pragma("unroll") for (int r = 0; r < 16; ++r) pA1[r] = __builtin_amdgcn_exp2f(pA1[r]);
  _Pragma("unroll") for (int d0 = 0; d0 < 4; ++d0) qlds[64 * d0] = qr[d0];
  WAIT_BAR(0);
  DMA_K(3, 0); DMA_V(1, SLOTB);
  ROT();
  kload8(kf, kp0 + sl_cur);
  WAIT_BAR(3);
  s16x4 vlo[8], vhi[8]; u32x4 pw0, pw1, pw2, pw3;
  #define PKW(P, B) cvtpk_s(P[B], P[B + 1])
  #define PAF(k) __builtin_bit_cast(bf16x8, pw##k)
  #define VFR(i) (bf16x8){vlo[i][0], vlo[i][1], vlo[i][2], vlo[i][3], vhi[i][0], vhi[i][1], vhi[i][2], vhi[i][3]}
  #define PIN(x) asm volatile("" : "+v"(x))
  #define MX3(a, b, c) __builtin_fmaxf(__builtin_fmaxf((a), (b)), (c))
  #define GAPA(MF, A0, A1, A2, A3, W0, W1, PW) do { MF; sacc += A0; sacc += A1; sacc += A2; sacc += A3; PIN(sacc); W0; W1; PIN(PW); SBAR(); } while (0)
  #define EX(v) __builtin_amdgcn_exp2f(v)
  #define GAPB(MF, X, B) do { MF; X[B] = EX(X[B]); X[B + 1] = EX(X[B + 1]); X[B + 2] = EX(X[B + 2]); X[B + 3] = EX(X[B + 3]); PIN(X); SBAR(); } while (0)
  #define VRD(i) do { vlo[i] = vtr(vp_ + (((i) >> 2) * 4096 + ((i) & 3) * 1024)); vhi[i] = vtr(vp_ + (((i) >> 2) * 4096 + ((i) & 3) * 1024 + 512)); } while (0)
  #define VRD2(i) do { vlo[i] = vtr(vp_ + (8192 + ((i) >> 2) * 4096 + ((i) & 3) * 1024)); vhi[i] = vtr(vp_ + (8192 + ((i) >> 2) * 4096 + ((i) & 3) * 1024 + 512)); SBAR(); } while (0)
  #define GAPB2(MF, X, B) do { MF; X[B] = EX(X[B]); X[B + 1] = EX(X[B + 1]); PIN(X); SBAR(); } while (0)
  #define KRD(G, j) do { if (G) { kload2(kf, kp0 + sl_next, j); SBAR(); } } while (0)
  #define STEP(C0, C1, P0, P1, t, GK, GV, GL) do { SBAR(); \
    const lds_cptr vp_ = vp0 + 2 * sl_prev; \
    const bf16x8 qf0 = qlds[0], qf1 = qlds[64], qf2 = qlds[128], qf3 = qlds[192]; \
    VRD(0); SBAR(); float sacc = (P0[0] + P0[1]); \
    GAPA(C0 = __builtin_amdgcn_mfma_f32_32x32x16_bf16(kf[0], qf0, negm, 0, 0, 0), P0[2], P0[3], P0[4], P0[5],     pw0[0] = PKW(P0, 0), pw0[1] = PKW(P0, 2), pw0); \
    VRD(4); SBAR(); GAPA(C1 = __builtin_amdgcn_mfma_f32_32x32x16_bf16(kf[1], qf0, negm, 0, 0, 0), P0[6], P0[7], P0[8], P0[9],     pw0[2] = PKW(P0, 4), pw0[3] = PKW(P0, 6), pw0); \
    VRD(1); SBAR(); GAPA(C0 = __builtin_amdgcn_mfma_f32_32x32x16_bf16(kf[2], qf1, C0, 0, 0, 0),   P0[10], P0[11], P0[12], P0[13], pw1[0] = PKW(P0, 8), pw1[1] = PKW(P0, 10), pw1); \
    VRD(5); SBAR(); GAPA(C1 = __builtin_amdgcn_mfma_f32_32x32x16_bf16(kf[3], qf1, C1, 0, 0, 0),   P0[14], P0[15], P1[0], P1[1],   pw1[2] = PKW(P0, 12), pw1[3] = PKW(P0, 14), pw1); \
    VRD(2); SBAR(); GAPA(C0 = __builtin_amdgcn_mfma_f32_32x32x16_bf16(kf[4], qf2, C0, 0, 0, 0),   P1[2], P1[3], P1[4], P1[5],     pw2[0] = PKW(P1, 0), pw2[1] = PKW(P1, 2), pw2); \
    VRD(6); SBAR(); GAPA(C1 = __builtin_amdgcn_mfma_f32_32x32x16_bf16(kf[5], qf2, C1, 0, 0, 0),   P1[6], P1[7], P1[8], P1[9],     pw2[2] = PKW(P1, 4), pw2[3] = PKW(P1, 6), pw2); \
    VRD(3); SBAR(); GAPA(C0 = __builtin_amdgcn_mfma_f32_32x32x16_bf16(kf[6], qf3, C0, 0, 0, 0),   P1[10], P1[11], P1[12], P1[13], pw3[0] = PKW(P1, 8), pw3[1] = PKW(P1, 10), pw3); \
    VRD(7); SBAR(); GAPA(C1 = __builtin_amdgcn_mfma_f32_32x32x16_bf16(kf[7], qf3, C1, 0, 0, 0),   P1[14], P1[15], 0.f, 0.f,       pw3[2] = PKW(P1, 12), pw3[3] = PKW(P1, 14), pw3); \
    l_reg += sacc; \
    if (GK) { DMA_K((t) + 3, sl_cur); } if (GV) { DMA_V((t) + 1, sl_next); } \
    asm volatile("s_nop 15\n\ts_nop 3" : "+v"(C0), "+v"(C1)); BIAS(C0, C1, t); \
    CMASK(C0, C1, t); \
    { float a = MX3(C0[0], C0[1], C1[0]), b = MX3(C0[2], C0[3], C1[1]); a = MX3(a, C1[2], C1[3]); \
      _Pragma("unroll") for (int r = 4; r < 16; r += 4) { a = MX3(a, C0[r], C0[r + 1]); b = MX3(b, C0[r + 2], C0[r + 3]); a = MX3(a, C1[r], C1[r + 1]); b = MX3(b, C1[r + 2], C1[r + 3]); } \
      float rm = __builtin_fmaxf(a, b); { auto rr = __builtin_amdgcn_permlane32_swap(__float_as_uint(rm), __float_as_uint(rm), false, false); rm = __builtin_fmaxf(__uint_as_float(rr[0]), __uint_as_float(rr[1])); } \
      resc = false; \
      if (__builtin_expect(__any(rm > (float)THRL), 0)) { const float dl = __builtin_fmaxf(rm, 0.f); mhat += dl; \
        _Pragma("unroll") for (int r = 0; r < 16; ++r) { C0[r] -= dl; C1[r] -= dl; } \
        const float f = __builtin_amdgcn_exp2f(-dl); l_reg *= f; if (hi == 0) wsf[r32] = f; resc = true; } } \
    SBAR(); \
    GAPB2(o[0] = __builtin_amdgcn_mfma_f32_32x32x16_bf16(PAF(0), VFR(0), o[0], 0, 0, 0), C0, 0); VRD2(0); \
    GAPB2(o[1] = __builtin_amdgcn_mfma_f32_32x32x16_bf16(PAF(0), VFR(4), o[1], 0, 0, 0), C0, 2); VRD2(4); \
    GAPB2(o[0] = __builtin_amdgcn_mfma_f32_32x32x16_bf16(PAF(1), VFR(1), o[0], 0, 0, 0), C0, 4); VRD2(1); \
    GAPB2(o[1] = __builtin_amdgcn_mfma_f32_32x32x16_bf16(PAF(1), VFR(5), o[1], 0, 0, 0), C0, 6); VRD2(5); \
    GAPB2(o[0] = __builtin_amdgcn_mfma_f32_32x32x16_bf16(PAF(2), VFR(2), o[0], 0, 0, 0), C0, 8); VRD2(2); \
    GAPB2(o[1] = __builtin_amdgcn_mfma_f32_32x32x16_bf16(PAF(2), VFR(6), o[1], 0, 0, 0), C0, 10); VRD2(6); \
    GAPB2(o[0] = __builtin_amdgcn_mfma_f32_32x32x16_bf16(PAF(3), VFR(3), o[0], 0, 0, 0), C0, 12); VRD2(3); \
    GAPB2(o[1] = __builtin_amdgcn_mfma_f32_32x32x16_bf16(PAF(3), VFR(7), o[1], 0, 0, 0), C0, 14); VRD2(7); \
    GAPB2(o[2] = __builtin_amdgcn_mfma_f32_32x32x16_bf16(PAF(0), VFR(0), o[2], 0, 0, 0), C1, 0); \
    GAPB2(o[3] = __builtin_amdgcn_mfma_f32_32x32x16_bf16(PAF(0), VFR(4), o[3], 0, 0, 0), C1, 2); \
    KRD(GL, 0); GAPB2(o[2] = __builtin_amdgcn_mfma_f32_32x32x16_bf16(PAF(1), VFR(1), o[2], 0, 0, 0), C1, 4); \
    KRD(GL, 1); GAPB2(o[3] = __builtin_amdgcn_mfma_f32_32x32x16_bf16(PAF(1), VFR(5), o[3], 0, 0, 0), C1, 6); \
    KRD(GL, 2); GAPB2(o[2] = __builtin_amdgcn_mfma_f32_32x32x16_bf16(PAF(2), VFR(2), o[2], 0, 0, 0), C1, 8); \
    KRD(GL, 3); GAPB2(o[3] = __builtin_amdgcn_mfma_f32_32x32x16_bf16(PAF(2), VFR(6), o[3], 0, 0, 0), C1, 10); \
    GAPB2(o[2] = __builtin_amdgcn_mfma_f32_32x32x16_bf16(PAF(3), VFR(3), o[2], 0, 0, 0), C1, 12); \
    GAPB2(o[3] = __builtin_amdgcn_mfma_f32_32x32x16_bf16(PAF(3), VFR(7), o[3], 0, 0, 0), C1, 14); \
    } while (0)
  int t = 1;
  #undef CMASK
  #define CMASK(P0, P1, t) do {} while (0)
  for (; t + 5 < NT; t += 2) {
    STEP(pB0, pB1, pA0, pA1, t, true, true, true);     WAIT_BAR(3); RESC(); ROT();
    STEP(pA0, pA1, pB0, pB1, t + 1, true, true, true); WAIT_BAR(3); RESC(); ROT();
  }
  #undef CMASK
  #define CMASK(P0, P1, t) do { int jb_ = (t) - (NT - 4); if (jb_ >= 0) cmask(P0, P1, jb_, qrel, hi); } while (0)
  #define ENDW(tt) do { if ((tt) + 3 < NT) { WAIT_BAR(3); } else if ((tt) + 2 < NT) { WAIT_BAR(2); } else { WAIT_BAR(0); } } while (0)
  for (; t + 1 < NT; t += 2) {
    STEP(pB0, pB1, pA0, pA1, t, (t + 3 < NT), (t + 1 < NT), (t + 1 < NT));     ENDW(t);     RESC(); ROT();
    STEP(pA0, pA1, pB0, pB1, t + 1, (t + 4 < NT), (t + 2 < NT), (t + 2 < NT)); ENDW(t + 1); RESC(); ROT();
  }
  STEP(pB0, pB1, pA0, pA1, NT - 1, false, false, false); RESC();
  { float sacc = pB0[0] + pB0[1]; _Pragma("unroll") for (int r = 2; r < 16; ++r) sacc += pB0[r]; _Pragma("unroll") for (int r = 0; r < 16; ++r) sacc += pB1[r]; l_reg += sacc;
    pw0 = (u32x4){PKW(pB0, 0), PKW(pB0, 2), PKW(pB0, 4), PKW(pB0, 6)}; pw1 = (u32x4){PKW(pB0, 8), PKW(pB0, 10), PKW(pB0, 12), PKW(pB0, 14)}; pw2 = (u32x4){PKW(pB1, 0), PKW(pB1, 2), PKW(pB1, 4), PKW(pB1, 6)}; pw3 = (u32x4){PKW(pB1, 8), PKW(pB1, 10), PKW(pB1, 12), PKW(pB1, 14)};
    SBAR(); pv(o, vb0 + 2 * sl_cur, PAF(0), PAF(1), PAF(2), PAF(3)); pv(o + 2, vb0 + 2 * sl_cur + 8192, PAF(0), PAF(1), PAF(2), PAF(3)); }
  #undef PKW
  #undef PAF
  #undef VFR
  #undef PIN
  #undef MX3
  #undef GAPA
  #undef GAPB
  #undef EX
  #undef VRD
  #undef VRD2
  #undef GAPB2
  #undef KRD
  #undef STEP
  #undef ENDW
  { auto rr = __builtin_amdgcn_permlane32_swap(__float_as_uint(l_reg), __float_as_uint(l_reg), false, false); l_reg = __uint_as_float(rr[0]) + __uint_as_float(rr[1]); }
  if (hi == 0) wsf[32 + r32] = l_reg; asm volatile("s_waitcnt lgkmcnt(0)" ::: "memory");
  float rli[16];
  #pragma unroll
  for (int r = 0; r < 16; ++r) rli[r] = __builtin_amdgcn_rcpf(wsf[32 + crow(r, hi)]);
  bf16* Ow = O + (rowbase + q0 + wid * QBLK) * op + oc;
  asm volatile("s_waitcnt lgkmcnt(0)\n\ts_barrier" ::: "memory");
  { bf16* stg = (bf16*)shm + wid * 4096;
    #pragma unroll
    for (int r = 0; r < 16; ++r) { const int orow = crow(r, hi);
      #pragma unroll
      for (int d0 = 0; d0 < 4; ++d0) stg[orow * 128 + d0 * 32 + r32] = __float2bfloat16(o[d0][r] * rli[r]); }
    asm volatile("s_waitcnt lgkmcnt(0)" ::: "memory");
    #pragma unroll
    for (int i = 0; i < 8; ++i) { const int row = i * 4 + (lane >> 4), ch = lane & 15; const u32x4 v = *(const u32x4*)(stg + row * 128 + ch * 8); ATTN_STORE16(Ow + (long)row * op + ch * 8, v); } }
  asm volatile("s_waitcnt lgkmcnt(0)\n\ts_barrier" ::: "memory");
  #undef DMA_K
  #undef DMA_V
  #undef CMASK
  #undef BIAS
  #undef START
  #undef RESC
  #undef ROT
}
#undef SBAR
#undef WAIT_BAR
}

#define XB_TMO      128
#define XB_XCNT(j)  (256  + 64 * (j))
#define XB_XSUB(j)  (1280 + 64 * (j))
#define XB_XGEN(j)  (2304 + 64 * (j))
#define XB_TOP      3328
#define XB_TOPGEN   3392
#define XCD_BAR_WORDS 3456
#define XB_SPIN_CAP (1u << 18)
__device__ __forceinline__ unsigned xb_ld(unsigned* p)              { return __hip_atomic_load(p, __ATOMIC_RELAXED, __HIP_MEMORY_SCOPE_AGENT); }
__device__ __forceinline__ unsigned xb_add(unsigned* p, unsigned v) { return __hip_atomic_fetch_add(p, v, __ATOMIC_RELAXED, __HIP_MEMORY_SCOPE_AGENT); }
__device__ __forceinline__ unsigned xb_xcc_id() { return (unsigned)__builtin_amdgcn_s_getreg((3 << 11) | 20) & 0xFu; }
#define XB_SPIN(cond, bar) do { unsigned _sp = 0; while (cond) { __builtin_amdgcn_s_sleep(1); \
    if ((++_sp & 255u) == 0u) { if (xb_ld(&(bar)[XB_TMO])) break; if (_sp > XB_SPIN_CAP) { atomicAdd(&(bar)[XB_TMO], 1u); break; } } } } while (0)
struct XcdBarrier { unsigned* bar; unsigned x; volatile LAS unsigned* st; };
__device__ __forceinline__ XcdBarrier xcd_barrier_post(unsigned* bar, volatile LAS unsigned* st, const bool t0) {
    XcdBarrier b; b.bar = bar; b.x = xb_xcc_id(); b.st = st;
    if (t0) (void)xb_add(&bar[XB_XCNT(b.x)], 1u);
    return b;
}
__device__ __forceinline__ void xcd_barrier_complete(unsigned* bar, unsigned x, unsigned& nloc, unsigned& nx) {
    const unsigned G = gridDim.x * gridDim.y * gridDim.z;
    unsigned sum, cnt, mine, sp = 0u;
    for (;;) {
        sum = 0u; cnt = 0u; mine = 0u;
#pragma unroll
        for (unsigned j = 0; j < 16; ++j) { const unsigned c = xb_ld(&bar[XB_XCNT(j)]); sum += c; cnt += (c > 0u) ? 1u : 0u; mine = (j == x) ? c : mine; }
        if (sum == G) break;
        __builtin_amdgcn_s_sleep(1);
        if ((++sp & 255u) == 0u) { if (xb_ld(&bar[XB_TMO])) break; if (sp > XB_SPIN_CAP) { atomicAdd(&bar[XB_TMO], 1u); break; } }
    }
    nloc = mine > 0u ? mine : 1u; nx = cnt > 0u ? cnt : 1u;
}
template <int JOB> __device__ __forceinline__ void barrier_job(const struct Ctx& c);
template <int JOB> __device__ __forceinline__ void xcd_barrier(const XcdBarrier& b, const bool t0, const struct Ctx& c) {
    asm volatile("s_waitcnt vmcnt(0)" ::: "memory");
    __syncthreads();
    if (t0) {
        unsigned* bar = b.bar;
        __builtin_amdgcn_s_waitcnt(0);
        unsigned nloc = b.st[0], nx = b.st[1];
        if (nloc == 0u) { xcd_barrier_complete(bar, b.x, nloc, nx); b.st[0] = nloc; b.st[1] = nx; }
        const unsigned old = xb_add(&bar[XB_XSUB(b.x)], 1u);
        const unsigned gen = old / nloc;
        if (old == gen * nloc && nloc > 1u) asm volatile("buffer_wbl2 sc1" ::: "memory");
        if (old + 1u == (gen + 1u) * nloc) {
            __builtin_amdgcn_fence(__ATOMIC_RELEASE, "agent");
            asm volatile("s_waitcnt vmcnt(0)" ::: "memory");
            const unsigned og = xb_add(&bar[XB_TOP], 1u);
            const unsigned tg = og / nx;
            if (og + 1u == (tg + 1u) * nx) xb_add(&bar[XB_TOPGEN], 1u);
            else XB_SPIN(xb_ld(&bar[XB_TOPGEN]) == tg, bar);
            __builtin_amdgcn_fence(__ATOMIC_ACQUIRE, "agent");
            asm volatile("s_waitcnt vmcnt(0)" ::: "memory");
        } else {
            XB_SPIN(xb_ld(&bar[XB_TOPGEN]) == gen, bar);
            __builtin_amdgcn_fence(__ATOMIC_ACQUIRE, "agent");
            asm volatile("s_waitcnt vmcnt(0)" ::: "memory");
        }
    }
    if constexpr (JOB != 0) barrier_job<JOB>(c);
    __syncthreads();
}

__device__ __forceinline__ void cvt_item(const float* W, int K, int N, bf16* WT, bool qkperm, const float* nw, LAS float* scr, int item, int lane) {
    const int nblk = N / 32, kb = item / nblk, nb = item % nblk, k0 = 64 * kb, n0 = 32 * nb;
    float wv_[32];
#pragma unroll
    for (int i = 0; i < 32; ++i) { const int kk = 2 * i + (lane >> 5); wv_[i] = W[(size_t)(k0 + kk) * N + n0 + (lane & 31)]; }
#pragma unroll
    for (int i = 0; i < 32; ++i) { const int kk = 2 * i + (lane >> 5); scr[kk * 33 + (lane & 31)] = wv_[i]; }
    LDS_WAIT(); asm volatile("" ::: "memory");
    int rb = n0; if (qkperm && n0 < 2048) { const int c = n0 & 255; rb = (n0 & ~255) + ((c >> 5) & 1) * 128 + (c >> 6) * 32; }
    const int c = lane & 7;
    f32x4 w0 = (f32x4){1.f, 1.f, 1.f, 1.f}, w1 = w0; if (nw) { w0 = *(const GAS f32x4*)(nw + k0 + 8 * c); w1 = *(const GAS f32x4*)(nw + k0 + 8 * c + 4); }
#pragma unroll
    for (int j = 0; j < 4; ++j) { const int n = (lane >> 3) + 8 * j; const LAS float* s = scr + (8 * c) * 33 + n;
        v4u o; o.x = pk2(s[0 * 33] * w0[0], s[1 * 33] * w0[1]); o.y = pk2(s[2 * 33] * w0[2], s[3 * 33] * w0[3]); o.z = pk2(s[4 * 33] * w1[0], s[5 * 33] * w1[1]); o.w = pk2(s[6 * 33] * w1[2], s[7 * 33] * w1[3]);
        *(GAS v4u*)(WT + (size_t)(rb + n) * K + k0 + 8 * c) = o; }
    LDS_WAIT(); asm volatile("" ::: "memory");
}
__device__ __forceinline__ void cvt_pair(const float* W0, int K0, int N0, bf16* T0, bool perm0, const float* nw0, const float* W1, int K1, int N1, bf16* T1, LAS unsigned char* lds, int gw, int ngw, int wave, int lane) {
    LAS float* scr = (LAS float*)(lds + wave * 16384);
    const int i0 = (K0 / 64) * (N0 / 32), i1 = (K1 / 64) * (N1 / 32);
    for (int it = gw; it < i0 + i1; it += ngw) { if (it < i0) cvt_item(W0, K0, N0, T0, perm0, nw0, scr, it, lane); else cvt_item(W1, K1, N1, T1, false, nullptr, scr, it - i0, lane); }
}
__device__ __forceinline__ void prep_rows(const float* x, bf16* XB, float* SQ, int gw, int ngw, int lane) {
    for (int m0 = gw; m0 < M; m0 += 4 * ngw) {
        f32x4 v[4][4];
#pragma unroll
        for (int q = 0; q < 4; ++q) { const int m = m0 + q * ngw; if (m < M) { const GAS f32x4* xr = (const GAS f32x4*)(x + (size_t)m * D) + lane;
#pragma unroll
            for (int j = 0; j < 4; ++j) v[q][j] = xr[64 * j]; } }
#pragma unroll
        for (int q = 0; q < 4; ++q) { const int m = m0 + q * ngw; if (m < M) { float s = 0.f;
#pragma unroll
            for (int j = 0; j < 4; ++j) s += (v[q][j].x * v[q][j].x + v[q][j].y * v[q][j].y) + (v[q][j].z * v[q][j].z + v[q][j].w * v[q][j].w);
            const float ssum = wave_sum(s);
            GAS v2u* o8 = (GAS v2u*)(XB + (size_t)m * D) + lane;
#pragma unroll
            for (int j = 0; j < 4; ++j) { v2u o; o.x = pk2(v[q][j].x, v[q][j].y); o.y = pk2(v[q][j].z, v[q][j].w); o8[64 * j] = o; }
            if (lane == 0) *((GAS f32x4*)SQ + m) = (f32x4){ssum, 0.f, 0.f, 0.f}; } }
    }
}
struct Args { const float* in[18]; float* out; unsigned char* ws; int ph_lo, ph_hi; };
struct Ctx { LAS unsigned char* L; gu32* ctl; int wave, G, bx, vcu, gw, ngw, lo, hi; XcdBarrier bar; };
typedef __attribute__((address_space(4))) const unsigned char* kptr_t;
__device__ __forceinline__ kptr_t kargs() { kptr_t p = (kptr_t)__builtin_amdgcn_kernarg_segment_ptr(); asm volatile("" : "+s"(p)); return p; }
template <class T> __device__ __forceinline__ T kld(kptr_t p, int off) { return *(const __attribute__((address_space(4))) T*)(p + off); }
#define KP_IN(k) kld<const float*>(kp, 8 * (k))
#define PHB if (PH_ON) { const int lane = lane_now(), tid = c.wave * 64 + lane; (void)tid; const kptr_t kp = kargs(); unsigned char* const ws = kld<unsigned char*>(kp, 152); float* const xo = kld<float*>(kp, 144); (void)xo; (void)ws;
#define P_H ((bf16*)(ws + WS_H))
#define P_WIN ((bf16*)(ws + WS_WIN))
#define P_WOUT ((bf16*)(ws + WS_WOUT))
#define P_WUP ((bf16*)(ws + WS_WUP))
#define P_WDN ((bf16*)(ws + WS_WDN))
#define P_QT ((bf16*)(ws + WS_QT))
#define P_KTK ((bf16*)(ws + WS_KTK))
#define P_KF ((bf16*)(ws + WS_KF))
#define P_VT ((bf16*)(ws + WS_VT))
#define P_G ((bf16*)(ws + WS_G))
#define P_P ((bf16*)(ws + WS_P))
#define P_ST ((bf16*)xo)
#define P_SS ((float*)(ws + WS_SS))
#define P_AQ ((bf16*)(ws + WS_AQ))
#define P_AK ((bf16*)(ws + WS_AK))
#define P_AV ((bf16*)(ws + WS_AV))
#define P_OB ((bf16*)(ws + WS_OB))
#define P_Y ((bf16*)(ws + WS_Y))
#define P_KM ((bf16*)(ws + WS_KM))
#define P_U ((bf16*)(ws + WS_U))
#define P_RN ((float*)(ws + WS_RN))
#define P_SQ ((float*)(ws + WS_SQ))
#define PH_ON (ph >= c.lo && ph < c.hi)
enum { J_NONE = 0, J_UP = 1  , J_DN = 5  , J_MIX1 = 9, J_MIX2 = 10, J_MIXIN3 = 11, J_MIXOUT3 = 12 };
constexpr size_t DS_W1IN = 0, DS_W1OUT = 6 * MiB, DS_W2IN = 8 * MiB, DS_W2OUT = 14 * MiB, DS_W3IN = 16 * MiB;
template <int JOB> __device__ __forceinline__ void ph_end(const Ctx& c, int& ph) {
    if (PH_ON && ph + 1 < c.hi) { const bool t0 = (c.wave == 0) && (lane_now() == 0); if (MK_PER_PHASE) { if (t0) __hip_atomic_store(c.ctl + CW_TMO, 0xBADBA0u, RLX_AGENT); } else xcd_barrier<JOB>(c.bar, t0, c); }
    ++ph;
}
#define PH_END ph_end<J_NONE>(c, ph)
#define PH_END_J(J) ph_end<(J)>(c, ph)
template <int JOB> __device__ __forceinline__ void barrier_job(const Ctx& c) {
    if (c.wave == 0) return;
    const int lane = lane_now(); const kptr_t kp = kargs(); unsigned char* const ws = kld<unsigned char*>(kp, 152); unsigned char* const dsc = (unsigned char*)kld<float*>(kp, 144);
    const int gw7 = c.vcu * (NWAVES - 1) + (c.wave - 1), ngw7 = c.G * (NWAVES - 1);
    if constexpr (JOB >= J_UP && JOB < J_UP + 4) { constexpr int LY = JOB - J_UP;
        cvt_pair(KP_IN(4) + (size_t)LY * D * FF, D, FF, P_WUP, false, KP_IN(3) + LY * D, nullptr, 0, 0, nullptr, c.L, gw7, ngw7, c.wave, lane); }
    else if constexpr (JOB >= J_DN && JOB < J_DN + 4) { constexpr int LY = JOB - J_DN;
        cvt_pair(KP_IN(5) + (size_t)LY * FF * D, FF, D, P_WDN, false, nullptr, nullptr, 0, 0, nullptr, c.L, gw7, ngw7, c.wave, lane); }
    else if constexpr (JOB == J_MIX1) cvt_pair(KP_IN(8), D, 3 * D, (bf16*)(dsc + DS_W1IN), true, KP_IN(2) + 1 * D, KP_IN(11), D, D, (bf16*)(dsc + DS_W1OUT), c.L, gw7, ngw7, c.wave, lane);
    else if constexpr (JOB == J_MIX2) cvt_pair(KP_IN(12), D, 3 * D, (bf16*)(dsc + DS_W2IN), true, KP_IN(2) + 2 * D, KP_IN(17), D, D, (bf16*)(dsc + DS_W2OUT), c.L, gw7, ngw7, c.wave, lane);
    else if constexpr (JOB == J_MIXIN3) cvt_pair(KP_IN(6) + (size_t)1 * D * RIN, D, RIN, (bf16*)(dsc + DS_W3IN), false, KP_IN(2) + 3 * D, nullptr, 0, 0, nullptr, c.L, gw7, ngw7, c.wave, lane);
    else if constexpr (JOB == J_MIXOUT3) cvt_pair(KP_IN(7) + (size_t)1 * RH * RDV * D, RH * RDV, D, P_WOUT, false, nullptr, nullptr, 0, 0, nullptr, c.L, gw7, ngw7, c.wave, lane);
}

template <int KIND> __device__ __forceinline__ void cvt_mixer(const kptr_t kp, unsigned char* const ws, const Ctx& c, const int lane, int j, const float* nw, bf16* const win_dst) {
    if constexpr (KIND == 0) cvt_pair(KP_IN(6) + (size_t)j * D * RIN, D, RIN, win_dst, false, nw, KP_IN(7) + (size_t)j * RH * RDV * D, RH * RDV, D, P_WOUT, c.L, c.gw, c.ngw, c.wave, lane);
    else if constexpr (KIND == 1) cvt_pair(KP_IN(8), D, 3 * D, P_WIN, true, nw, KP_IN(11), D, D, P_WOUT, c.L, c.gw, c.ngw, c.wave, lane);
    else cvt_pair(KP_IN(12), D, 3 * D, P_WIN, true, nw, KP_IN(17), D, D, P_WOUT, c.L, c.gw, c.ngw, c.wave, lane);
}
#define CVT_MLP() cvt_pair(KP_IN(4) + (size_t)LAYER * D * FF, D, FF, P_WUP, false, KP_IN(3) + LAYER * D, KP_IN(5) + (size_t)LAYER * FF * D, FF, D, P_WDN, c.L, c.gw, c.ngw, c.wave, lane)

#define PRELOAD_SQ(NMAX, ROW, FUNC) { pg8::Unit u_; LAS float* tb_ = (LAS float*)(L + 139264); f32x4 a_[NMAX]; bool v_[NMAX]; \
    _Pragma("unroll") for (int i_ = 0; i_ < NMAX; ++i_) { v_[i_] = S.next(i_, u_); a_[i_] = (f32x4){1.f, 1.f, 1.f, 1.f}; if (v_[i_] && tid < 256) a_[i_] = *((const GAS f32x4*)P_SQ + ((ROW) * 256 + tid)); } \
    _Pragma("unroll") for (int i_ = 0; i_ < NMAX; ++i_) if (v_[i_] && tid < 256) tb_[i_ * 256 + tid] = FUNC(((a_[i_].x + a_[i_].y) + (a_[i_].z + a_[i_].w)) * (1.f / D) + EPS); \
    __syncthreads(); }
template <int LAYER> __device__ __forceinline__ void ret_rest(const Ctx& c, int& ph) {
    PHB
        for (int item = c.bx * (NWAVES * 64) + tid; item < 16 * 16384; item += c.G * NWAVES * 64) {
            const int bhl = item >> 14, v = item & 16383, h = bhl & 3;
            const float g256 = __builtin_amdgcn_exp2f(256.f * __builtin_amdgcn_logf(1.0f - __builtin_amdgcn_exp2f(-5.0f - (float)h)));
            GAS v4u* p = (GAS v4u*)(P_ST + (size_t)bhl * 16 * 131072) + v;
            v4u t[16];
#pragma unroll
            for (int n = 0; n < 16; ++n) t[n] = p[(size_t)n * 16384];
            float s[8] = {0.f, 0.f, 0.f, 0.f, 0.f, 0.f, 0.f, 0.f};
#pragma unroll
            for (int n = 0; n < 16; ++n) {
                v4u o; o.x = pk2(s[0], s[1]); o.y = pk2(s[2], s[3]); o.z = pk2(s[4], s[5]); o.w = pk2(s[6], s[7]);
                p[(size_t)n * 16384] = o;
                s[0] = g256 * (s[0] + bflo(t[n].x)); s[1] = g256 * (s[1] + bfhi(t[n].x)); s[2] = g256 * (s[2] + bflo(t[n].y)); s[3] = g256 * (s[3] + bfhi(t[n].y));
                s[4] = g256 * (s[4] + bflo(t[n].z)); s[5] = g256 * (s[5] + bfhi(t[n].z)); s[6] = g256 * (s[6] + bflo(t[n].w)); s[7] = g256 * (s[7] + bfhi(t[n].w));
            }
        }
    }
    PH_END_J(J_DN + LAYER);
    PHB
        pg8::SchedRetO S{(const char*)P_P, (const char*)P_QT, (const char*)P_VT, (const char*)P_ST, c.G, c.vcu};
        pg8::EpiRetOut E{P_G, P_SS};
        pg8::gemm_phase<pg8::EpiRetOut, pg8::SchedRetO, true, true>(c.L + RING_OFF, c.wave, pg8::GemmP{256, 256, 4, 4}, S, E);
    }
    PH_END;
}

template <int LAYER> __device__ __forceinline__ void do_layer(const Ctx& c, int& ph) {
    extern __shared__ __attribute__((aligned(16))) unsigned char lds[];
    constexpr int KIND = LAYER % 3, J = LAYER / 3;
    const int G = c.G, bx = c.bx, gw = c.gw, ngw = c.ngw;
    LAS unsigned char* const L = c.L;
    if constexpr (KIND == 0) {
        PHB
            pg8::SchedRetIn S{(const char*)P_H, (LAYER == 3) ? (const char*)xo + DS_W3IN : (const char*)P_WIN, G, bx};
            PRELOAD_SQ(6, (u_.ty >= 3 ? u_.pn : u_.pm), __builtin_amdgcn_rsqf)
            pg8::EpiRetIn E{P_QT, P_KTK, P_KF, P_VT, P_G, (const LAS float*)(L + 139264), L + 147456};
            pg8::gemm_phase<pg8::EpiRetIn, pg8::SchedRetIn, true, true>(L + RING_OFF, c.wave, pg8::GemmP{1024, 1024, 16, 0}, S, E);
        }
        PH_END;
        PHB
            pg8::SchedRetPS S{(const char*)P_QT, (const char*)P_KTK, (const char*)P_VT, (const char*)P_KF, G, c.vcu};
            pg8::EpiMaskState E{pg8::EpiMask{P_P}, pg8::EpiState{P_ST}};
            pg8::gemm_phase<pg8::EpiMaskState, pg8::SchedRetPS, true, true>(L + RING_OFF, c.wave, pg8::GemmP{256, 256, 4, 0}, S, E);
        }
        PH_END_J(J_UP + LAYER);
        ret_rest<LAYER>(c, ph);
        PHB
            pg8::SchedPlain S{(const char*)P_G, (const char*)P_WOUT, 64, 4, G, bx, (size_t)256 * 2048 * 2, (size_t)256 * 2048 * 2};
            { pg8::Unit u_; LAS float* tb_ = (LAS float*)(L + 139264);
              if (S.next(0, u_) && tid < 256) { float r_[4];
#pragma unroll
                  for (int h_ = 0; h_ < 4; ++h_) { const GAS f32x4* sp_ = (const GAS f32x4*)(P_SS + (size_t)((u_.pm * 256 + tid) * 4 + h_) * 8); const f32x4 s0_ = sp_[0], s1_ = sp_[1];
                      r_[h_] = __builtin_amdgcn_rsqf(((s0_.x + s0_.y) + (s0_.z + s0_.w) + (s1_.x + s1_.y) + (s1_.z + s1_.w)) * (1.f / 512.f) + EPS); }
                  tb_[tid] = r_[0] / r_[1]; tb_[256 + tid] = r_[1] / r_[2]; tb_[512 + tid] = r_[2] / r_[3]; tb_[768 + tid] = r_[3]; }
              __syncthreads(); }
            pg8::EpiResH E{P_H, xo, P_SQ, (LAS float*)(L + 135168), (const LAS float*)(L + 139264)};
            pg8::gemm_phase<pg8::EpiResH, pg8::SchedPlain, true, true>(L + RING_OFF, c.wave, pg8::GemmP{2048, 2048, 32, 0}, S, E);
        }
        PH_END_J(LAYER == 0 ? J_MIX1 : J_NONE);
    } else {
        PHB
            pg8::SchedPlain S{(const char*)P_H, (const char*)xo + (KIND == 1 ? DS_W1IN : DS_W2IN), 64, 12, G, bx, (size_t)256 * 1024 * 2, (size_t)256 * 1024 * 2};
            PRELOAD_SQ(3, u_.pm, __builtin_amdgcn_rsqf)
            if (KIND == 1) ((LAS float*)(L + 135168))[tid] = 0.f;
            pg8::EpiQKNorm<KIND == 1> E{P_AQ, P_AK, P_AV, (KIND == 1) ? KP_IN(9) : KP_IN(13), (KIND == 1) ? KP_IN(10) : KP_IN(14), (const LAS float*)(L + 139264), (KIND == 1) ? (pg8::bf16_t*)P_KM : nullptr, (LAS float*)(L + 135168)};
            pg8::gemm_phase<pg8::EpiQKNorm<KIND == 1>, pg8::SchedPlain, true, true>(L + RING_OFF, c.wave, pg8::GemmP{1024, 1024, 16, 0}, S, E);
        }
        PH_END_J(KIND == 2 ? J_MIXIN3 : J_UP + LAYER);
        const int abh = c.vcu >> 2, as_ = c.vcu & 3, ab = abh >> 4, ah = abh & 15;
        if constexpr (KIND == 1) {
        PHB
            if (G == 256) {
                const float* const rel_bias = KP_IN(1);
                LAS float* tab = (LAS float*)(L + attn_body::LDS_TAB);
                for (int xx = tid; xx < attn_body::TAB_N; xx += NWAVES * 64) { const int d = xx - 256; float v = 0.f;
                    if (d >= 0) { int bk = d; if (d >= 16) { bk = 16 + (d >= 21) + (d >= 27) + (d >= 35) + (d >= 46) + (d >= 59) + (d >= 77) + (d >= 99) + (d >= 128) + (d >= 166) + (d >= 216) + (d >= 280) + (d >= 363) + (d >= 470) + (d >= 609) + (d >= 790); }
                        v = (rel_bias[bk * 16 + ah] - rel_bias[31 * 16 + ah]) * LOG2E; }
                    tab[xx] = v; }
                __syncthreads();
                for (int i = 0; i < 4; ++i) { const int qb = (i == 0) ? as_ : (i == 1) ? 7 - as_ : (i == 2) ? 8 + as_ : 15 - as_;
                    attn_body::attn_unit<1, 8, 1024>(ab, qb, (const attn_body::bf16*)P_AQ, ah * 64, (const attn_body::bf16*)P_AK, ah * 64, (const attn_body::bf16*)P_AV, ah * 64,
                                               (attn_body::bf16*)P_OB, ah * 64, (const attn_body::bf16*)P_KM + (size_t)ab * 64 * 1024 + ah * 64, (char*)lds, c.wave);
                }
            }
        }
        PH_END_J(J_DN + LAYER);
        } else {
        PHB
            if (G == 256) {
                const int pr_ = c.vcu >> 3, as8 = c.vcu & 7, ab2 = pr_ >> 3, hd2 = pr_ & 7;
                const float* const rel_bias = KP_IN(1);
                LAS float* tab = (LAS float*)(L + attn_body::V2_TAB);
                for (int hh = 0; hh < 2; ++hh) { const int ah = 2 * hd2 + hh;
                    __syncthreads();
                for (int xx = tid; xx < attn_body::TAB_N; xx += NWAVES * 64) { const int d = xx - 256; float v = 0.f;
                    if (d >= 0) { int bk = d; if (d >= 16) { bk = 16 + (d >= 21) + (d >= 27) + (d >= 35) + (d >= 46) + (d >= 59) + (d >= 77) + (d >= 99) + (d >= 128) + (d >= 166) + (d >= 216) + (d >= 280) + (d >= 363) + (d >= 470) + (d >= 609) + (d >= 790); }
                        v = (rel_bias[bk * 16 + ah] - rel_bias[31 * 16 + ah]) * LOG2E; }
                    tab[xx] = v; }
                    __syncthreads();
                    for (int i = 0; i < 2; ++i) { const int qb = i ? 15 - as8 : as8;
                        attn_body::attn_unit_v128<8>(ab2, qb, (const attn_body::bf16*)P_AQ, ah * 64, (const attn_body::bf16*)P_AK, ah * 64, (const attn_body::bf16*)P_AV, hd2 * 128,
                                                     (attn_body::bf16*)P_OB, ah * 128, (char*)lds, c.wave);
                    }
                }
                asm volatile("s_waitcnt vmcnt(0)" ::: "memory"); __syncthreads();
                __builtin_amdgcn_fence(__ATOMIC_ACQUIRE, "agent"); asm volatile("s_waitcnt vmcnt(0)" ::: "memory");
                const int ln_ = lane_now();
                const float* lam = KP_IN(15); const float* subln = KP_IN(16);
                const float linit = 0.8f - 0.6f * 0.5488116360940264f;
                const float s01 = wave_sum(lam[ln_] * lam[64 + ln_]), s23 = wave_sum(lam[128 + ln_] * lam[192 + ln_]);
                const float lfull = __builtin_amdgcn_exp2f(s01 * LOG2E) - __builtin_amdgcn_exp2f(s23 * LOG2E) + linit;
                const int seg = ln_ & 7;
                f32x4 sw[4];
#pragma unroll
                for (int j = 0; j < 4; ++j) sw[j] = *((const GAS f32x4*)(subln + seg * 16) + j);
                for (int hf = 0; hf < 2; ++hf) { const int qb = hf ? 15 - as8 : as8; const size_t m0 = (size_t)ab2 * SEQ + qb * 256 + c.wave * 8 + (ln_ >> 3);
                    v4u u1[4][2], u2[4][2];
#pragma unroll
                    for (int q = 0; q < 4; ++q) { const size_t m = m0 + q * 64;
                        const GAS v4u* p1 = (const GAS v4u*)(P_OB + m * 2048 + (2 * hd2) * 128 + seg * 16);
                        const GAS v4u* p2 = (const GAS v4u*)(P_OB + m * 2048 + (2 * hd2 + 1) * 128 + seg * 16);
#pragma unroll
                        for (int j = 0; j < 2; ++j) { u1[q][j] = p1[j]; u2[q][j] = p2[j]; } }
#pragma unroll
                    for (int q = 0; q < 4; ++q) { const size_t m = m0 + q * 64;
                        float a[16]; float ss = 0.f;
#pragma unroll
                        for (int j = 0; j < 2; ++j) { const v4u w1 = u1[q][j], w2 = u2[q][j];
                            a[8 * j + 0] = bflo(w1.x) - lfull * bflo(w2.x); a[8 * j + 1] = bfhi(w1.x) - lfull * bfhi(w2.x); a[8 * j + 2] = bflo(w1.y) - lfull * bflo(w2.y); a[8 * j + 3] = bfhi(w1.y) - lfull * bfhi(w2.y);
                            a[8 * j + 4] = bflo(w1.z) - lfull * bflo(w2.z); a[8 * j + 5] = bfhi(w1.z) - lfull * bfhi(w2.z); a[8 * j + 6] = bflo(w1.w) - lfull * bflo(w2.w); a[8 * j + 7] = bfhi(w1.w) - lfull * bfhi(w2.w); }
#pragma unroll
                        for (int j = 0; j < 16; ++j) ss += a[j] * a[j];
                        ss += __shfl_xor(ss, 1); ss += __shfl_xor(ss, 2); ss += __shfl_xor(ss, 4);
                        const float r = __builtin_amdgcn_rsqf(ss * (1.f / 128.f) + EPS) * (1.0f - linit);
                        GAS v4u* po = (GAS v4u*)(P_Y + m * 1024 + hd2 * 128 + seg * 16);
#pragma unroll
                        for (int j = 0; j < 2; ++j) { v4u o;
                            o.x = pk2(a[8 * j + 0] * r * sw[2 * j][0], a[8 * j + 1] * r * sw[2 * j][1]); o.y = pk2(a[8 * j + 2] * r * sw[2 * j][2], a[8 * j + 3] * r * sw[2 * j][3]);
                            o.z = pk2(a[8 * j + 4] * r * sw[2 * j + 1][0], a[8 * j + 5] * r * sw[2 * j + 1][1]); o.w = pk2(a[8 * j + 6] * r * sw[2 * j + 1][2], a[8 * j + 7] * r * sw[2 * j + 1][3]); po[j] = o; }
                    }
                }
            }
        }
        PH_END_J(J_UP + LAYER);
        }
        PHB
            pg8::SchedPlain S{(const char*)((KIND == 1) ? P_OB : P_Y), (const char*)xo + (KIND == 1 ? DS_W1OUT : DS_W2OUT), 64, 4, G, bx, (size_t)256 * 1024 * 2, (size_t)256 * 1024 * 2};
            pg8::EpiRes<false> E{P_H, xo, P_SQ, (LAS float*)(L + 135168)};
            pg8::gemm_phase<pg8::EpiRes<false>, pg8::SchedPlain, true, true>(L + RING_OFF, c.wave, pg8::GemmP{1024, 1024, 16, 0}, S, E);
        }
        PH_END_J(KIND == 1 ? J_MIX2 : J_DN + LAYER);
    }
    PHB
        pg8::SchedPlain S{(const char*)P_H, (const char*)P_WUP, 64, 16, G, bx, (size_t)256 * 1024 * 2, (size_t)256 * 1024 * 2};
        PRELOAD_SQ(4, u_.pm, __builtin_amdgcn_rcpf)
        pg8::EpiUp E{P_U, (const LAS float*)(L + 139264)};
        pg8::gemm_phase<pg8::EpiUp, pg8::SchedPlain, true, true>(L + RING_OFF, c.wave, pg8::GemmP{1024, 1024, 16, 0}, S, E);
    }
    PH_END_J(LAYER == 2 ? J_MIXOUT3 : J_NONE);
    PHB
        pg8::SchedPlain S{(const char*)P_U, (const char*)P_WDN, 64, 4, G, bx, (size_t)256 * 4096 * 2, (size_t)256 * 4096 * 2};
        pg8::EpiRes<(LAYER == 3)> E{P_H, xo, P_SQ, (LAS float*)(L + 135168)};
        pg8::gemm_phase<pg8::EpiRes<(LAYER == 3)>, pg8::SchedPlain, true, true>(L + RING_OFF, c.wave, pg8::GemmP{4096, 4096, 64, 0}, S, E);
    }
    PH_END;
}

__global__ void __launch_bounds__(NWAVES * 64, 2) trunk_fwd(Args args) {
    extern __shared__ __attribute__((aligned(16))) unsigned char lds[];
    Ctx c;
    c.L = (LAS unsigned char*)lds;
    volatile LAS unsigned* const MISC = (volatile LAS unsigned*)(c.L + MISC_OFF);
    const int tid0 = threadIdx.x; c.wave = __builtin_amdgcn_readfirstlane(tid0 >> 6);
    c.G = gridDim.x; c.bx = blockIdx.x;
    c.vcu = (c.G % 8 == 0) ? (c.bx % 8) * (c.G / 8) + c.bx / 8 : c.bx;
    c.gw = c.vcu * NWAVES + c.wave; c.ngw = c.G * NWAVES;
    c.ctl = (gu32*)(args.ws + WS_CTL);
    for (int u = tid0; u < (LDS_BYTES - LDSCTL_OFF) / 4; u += NWAVES * 64) ((LAS unsigned*)(c.L + LDSCTL_OFF))[u] = 0u;
    __syncthreads();
    c.bar.bar = (unsigned*)(c.ctl + CW_BAR); c.bar.x = 0; c.bar.st = nullptr;
    if (!MK_PER_PHASE) c.bar = xcd_barrier_post((unsigned*)(c.ctl + CW_BAR), MISC + 8, tid0 == 0);
    c.lo = args.ph_lo; c.hi = args.ph_hi;
    int ph = 0;
    PHB cvt_mixer<0>(kp, ws, c, lane, 0, KP_IN(2), P_WIN); prep_rows(KP_IN(0), P_H, P_SQ, c.gw, c.ngw, lane);
        for (int i = c.bx * (NWAVES * 64) + tid; i < 4 * 48 * 128; i += c.G * NWAVES * 64) { const int b = i / (48 * 128), r = (i / 128) % 48, cc = i % 128;
            *((GAS v4u*)(P_KM + ((size_t)(b * 64 + 16 + r)) * 1024) + cc) = (v4u){0u, 0u, 0u, 0u}; } }
    PH_END;
    do_layer<0>(c, ph);
    do_layer<1>(c, ph);
    do_layer<2>(c, ph);
    do_layer<3>(c, ph);
}
#undef PH_ON
#undef PH_END


constexpr int N_PHASES = 1 + (5 + 2) + (3 + 2) + (3 + 2) + (5 + 2);
extern "C" void kernel_launch(void* const* d_in, const int* in_sizes, int n_in, void* d_out, int out_size, void* d_ws, size_t ws_size, hipStream_t stream) {
    static int grid = 0;
    if (grid == 0) {
        if (n_in != 18 || in_sizes[0] != M * D || out_size != M * D || ws_size < WS_END) { fprintf(stderr, "kernel_launch: unexpected shapes (n_in %d, in0 %d, out %d, ws %zu < %zu); nothing launched\n", n_in, n_in > 0 ? in_sizes[0] : -1, out_size, ws_size, (size_t)WS_END); grid = -1; return; }
        int dev = 0, cus = 0, per_cu = 0;
        if (hipGetDevice(&dev) != hipSuccess || hipDeviceGetAttribute(&cus, hipDeviceAttributeMultiprocessorCount, dev) != hipSuccess) { grid = -1; return; }
        if (hipFuncSetAttribute((const void*)trunk_fwd, hipFuncAttributeMaxDynamicSharedMemorySize, LDS_BYTES) != hipSuccess) { fprintf(stderr, "kernel_launch: hipFuncSetAttribute failed\n"); grid = -1; return; }
        if (hipOccupancyMaxActiveBlocksPerMultiprocessor(&per_cu, (const void*)trunk_fwd, NWAVES * 64, LDS_BYTES) != hipSuccess || per_cu < 1)
            fprintf(stderr, "kernel_launch: note: occupancy query reports %d workgroups per CU\n", per_cu);
        (void)hipGetLastError();
        grid = cus;
        if (grid != 256) fprintf(stderr, "kernel_launch: %d CUs; the attention phases need a 256-workgroup grid\n", grid);
    }
    if (grid < 0) return;
    if (hipMemsetAsync((char*)d_ws + WS_CTL, 0, CTL_ZERO_BYTES, stream) != hipSuccess) return;
    Args a{};
    for (int i = 0; i < 18; ++i) a.in[i] = (const float*)d_in[i];
    a.out = (float*)d_out; a.ws = (unsigned char*)d_ws;
#if MK_PER_PHASE
    for (int p = 0; p < N_PHASES; ++p) { a.ph_lo = p; a.ph_hi = p + 1; hipLaunchKernelGGL(trunk_fwd, dim3(grid), dim3(NWAVES * 64), LDS_BYTES, stream, a); }
#else
    a.ph_lo = 0; a.ph_hi = N_PHASES;
    hipLaunchKernelGGL(trunk_fwd, dim3(grid), dim3(NWAVES * 64), LDS_BYTES, stream, a);
#endif
    const hipError_t le = hipPeekAtLastError();
    if (le != hipSuccess) fprintf(stderr, "kernel_launch: launch failed: %s\n", hipGetErrorName(le));
}
```

```cpp
#include <hip/hip_runtime.h>
#include <hip/hip_bf16.h>
#include <cstdio>
#include <cstdint>

__device__ __forceinline__ int lane_now() { int l; asm volatile("v_mbcnt_lo_u32_b32 %0, -1, 0\n\tv_mbcnt_hi_u32_b32 %0, -1, %0" : "=v"(l)); return l; }

#ifndef MK_PER_PHASE
#define MK_PER_PHASE 0
#endif

namespace pg8 {
#define PG8_LAS __attribute__((address_space(3)))
typedef unsigned short bf16_t;
typedef short bf16x8 __attribute__((ext_vector_type(8)));
typedef float f32x4 __attribute__((ext_vector_type(4)));
typedef unsigned u32x4 __attribute__((ext_vector_type(4)));
constexpr int BM = 256, BK = 64, HALF = 128, HTB = HALF * BK * 2  , STAGE_BYTES = 8 * HTB, NXCD = 8, WGM = 8;

__host__ __device__ __forceinline__ int lds_byte(int r, int c) { const int st = (r >> 4) * 2 + (c >> 5), rr = r & 15, cc = c & 31, ob = rr * 64 + cc * 2; return st * 1024 + (ob ^ (((ob >> 9) & 1) << 5)); }
__host__ __device__ __forceinline__ void stage_rc(int b, int& R, int& C) { const int st = b / 1024, sb = b % 1024, swz = sb ^ (((sb >> 9) & 1) << 5); R = (st >> 1) * 16 + swz / 64; C = (st & 1) * 32 + (swz % 64) / 2; }
__host__ __device__ __forceinline__ int perm32(int rho) { const int n = rho >> 4, i = rho & 15; return 8 * (i >> 2) + 4 * n + (i & 3); }

struct Unit { const char* a0; const char* b0; const char* a1; const char* b1; int pm, pn, ty, z; };
struct GemmP { int lda, ldb, nt1, nt2; };

__host__ __device__ __forceinline__ void tile_of(int L, int nM, int nN, int& pm, int& pn) {
    const int nwg = nM * nN; int wgid = L; { const int q = nwg / NXCD, r = nwg % NXCD, xcd = wgid % NXCD, off = wgid / NXCD; wgid = (xcd < r ? xcd * (q + 1) : r * (q + 1) + (xcd - r) * q) + off; }
    const int nig = WGM * nN, gid = wgid / nig, fm = gid * WGM, gsz = (nM - fm) < WGM ? (nM - fm) : WGM;
    pm = fm + ((wgid % nig) % gsz); pn = (wgid % nig) / gsz;
}

__device__ __forceinline__ unsigned cvt_pk_bf16(float lo, float hi) { unsigned r; asm volatile("v_cvt_pk_bf16_f32 %0, %1, %2" : "=v"(r) : "v"(lo), "v"(hi)); return r; }
__device__ __forceinline__ u32x4 pack8(const f32x4 v0, const f32x4 v1) { u32x4 w; w.x = cvt_pk_bf16(v0[0], v0[1]); w.y = cvt_pk_bf16(v0[2], v0[3]); w.z = cvt_pk_bf16(v1[0], v1[1]); w.w = cvt_pk_bf16(v1[2], v1[3]); return w; }

template <class Epi, class Sched, bool ALIGN_EPI, bool SP2>
__device__ __forceinline__ void gemm_phase(PG8_LAS unsigned char* lds, const int wave, const GemmP g, const Sched& S, const Epi& E) {
    const int lane = lane_now(), wid = wave, tid = wave * 64 + lane, wr = wid >> 2, wc = wid & 3, fr = lane & 15, fq = lane >> 4;
    const int nt1 = g.nt1, nt = g.nt1 + g.nt2;
    unsigned voffA[2], voffB[2];
#pragma unroll
    for (int i = 0; i < 2; ++i) { int R, C; stage_rc(tid * 16 + i * 8192, R, C); const int Rb = Epi::PERM ? ((R & ~31) + perm32(R & 31)) : R;
        voffA[i] = (unsigned)(R * g.lda + C) * 2u; voffB[i] = (unsigned)(Rb * g.ldb + C) * 2u; }
    const size_t kstep = (size_t)(BK * 2);
    const size_t hstepA = (size_t)HALF * g.lda * 2, hstepB = (size_t)HALF * g.ldb * 2;
    const unsigned ldsw = (unsigned)wid * 1024u;
    const int aoff = lds_byte(wr * 64 + fr, fq * 8), boff = lds_byte(wc * 32 + fr, fq * 8);
#define PG8_SA(b, h) (((b) * 2 + (h)) * HTB)
#define PG8_SB(b, h) ((4 + (b) * 2 + (h)) * HTB)
#define PG8_STAGE(bufoff, gbase, voff) do { _Pragma("unroll") for (int _i = 0; _i < 2; ++_i) \
        __builtin_amdgcn_global_load_lds((const unsigned*)((const char*)(gbase) + (voff)[_i]), (PG8_LAS unsigned*)(lds + (bufoff) + ldsw + _i * 8192), 16, 0, 0); } while (0)
#define PG8_LDA(dst, b, h) do { _Pragma("unroll") for (int m = 0; m < 4; ++m) _Pragma("unroll") for (int k = 0; k < 2; ++k) dst[m][k] = *(const PG8_LAS bf16x8*)(lds + PG8_SA(b, h) + aoff + m * 2048 + k * 1024); } while (0)
#define PG8_LDB(dst, b, h) do { _Pragma("unroll") for (int n = 0; n < 2; ++n) _Pragma("unroll") for (int k = 0; k < 2; ++k) dst[n][k] = *(const PG8_LAS bf16x8*)(lds + PG8_SB(b, h) + boff + n * 2048 + k * 1024); } while (0)
#define PG8_MMA(ai, bj, At, Bt) do { __builtin_amdgcn_s_setprio(1); _Pragma("unroll") for (int m = 0; m < 4; ++m) _Pragma("unroll") for (int n = 0; n < 2; ++n) _Pragma("unroll") for (int k = 0; k < 2; ++k) \
        acc[ai][bj][m][n] = __builtin_amdgcn_mfma_f32_16x16x32_bf16(Bt[n][k], At[m][k], acc[ai][bj][m][n], 0, 0, 0); __builtin_amdgcn_s_setprio(0); } while (0)
#define PG8_WAIT_V(n) asm volatile("s_waitcnt vmcnt(" #n ")" ::: "memory")
#define PG8_WAIT_L(n) asm volatile("s_waitcnt lgkmcnt(" #n ")" ::: "memory")
#define PG8_BAR __builtin_amdgcn_s_barrier()
#define PG8_SCHED __builtin_amdgcn_sched_barrier(0)
    Unit cur, nxt; int ui = 0;
    if (!S.next(0, cur)) return;
    f32x4 acc[2][2][4][2];
#pragma unroll
    for (int a = 0; a < 2; ++a)
#pragma unroll
        for (int b = 0; b < 2; ++b)
#pragma unroll
            for (int m = 0; m < 4; ++m)
#pragma unroll
                for (int n = 0; n < 2; ++n) acc[a][b][m][n] = (f32x4){0.f, 0.f, 0.f, 0.f};
    bf16x8 At[4][2], B0[2][2], B1[2][2];
    const char* cA = cur.a0; const char* cB = cur.b0;
    if constexpr (SP2) {
        PG8_STAGE(PG8_SB(0, 0), cB, voffB); PG8_STAGE(PG8_SB(0, 1), cB + hstepB, voffB); PG8_STAGE(PG8_SA(0, 0), cA, voffA); PG8_STAGE(PG8_SA(0, 1), cA + hstepA, voffA);
        if (wr == 1) PG8_BAR;
        PG8_WAIT_V(2); PG8_BAR;
        PG8_STAGE(PG8_SB(1, 0), cB + kstep, voffB); PG8_STAGE(PG8_SA(1, 0), cA + kstep, voffA); PG8_STAGE(PG8_SB(1, 1), cB + hstepB + kstep, voffB);
        PG8_WAIT_V(6); PG8_BAR;
    } else {
        PG8_STAGE(PG8_SB(0, 0), cB, voffB); PG8_STAGE(PG8_SA(0, 0), cA, voffA); PG8_STAGE(PG8_SB(0, 1), cB + hstepB, voffB); PG8_STAGE(PG8_SA(0, 1), cA + hstepA, voffA);
        if (wr == 1) PG8_BAR;
        PG8_WAIT_V(4); PG8_BAR;
        PG8_STAGE(PG8_SB(1, 0), cB + kstep, voffB); PG8_STAGE(PG8_SA(1, 0), cA + kstep, voffA); PG8_STAGE(PG8_SB(1, 1), cB + hstepB + kstep, voffB);
        PG8_WAIT_V(6); PG8_BAR;
    }
    for (;;) {
        const bool has_next = S.next(ui + 1, nxt);
        const char* nA = has_next ? nxt.a0 : cur.a0; const char* nB = has_next ? nxt.b0 : cur.b0;
        for (int t = 0; t < nt; t += 2) {
            if constexpr (Epi::KHOOK) { if (t > 0 && (t & 7) == 0) E.khook(acc, t >> 3, wr, fr); }
            const bool last = (t == nt - 2);
            const bool s1 = (t >= nt1), s2 = (t + 2 >= nt1);
            const char* a1 = s1 ? cur.a1 + (size_t)(t + 1 - nt1) * kstep : cur.a0 + (size_t)(t + 1) * kstep;
            const char* a2 = last ? nA : (s2 ? cur.a1 + (size_t)(t + 2 - nt1) * kstep : cur.a0 + (size_t)(t + 2) * kstep);
            const char* b2 = last ? nB : (s2 ? cur.b1 + (size_t)(t + 2 - nt1) * kstep : cur.b0 + (size_t)(t + 2) * kstep);
            const char* a3 = a2 + kstep; const char* b3 = b2 + kstep;
            if constexpr (SP2) {
            PG8_LDB(B0, 0, 0); PG8_LDB(B1, 0, 1); PG8_SCHED; PG8_LDA(At, 0, 0); PG8_STAGE(PG8_SA(1, 1), a1 + hstepA, voffA);
            PG8_WAIT_V(8); PG8_WAIT_L(0); PG8_BAR; PG8_MMA(0, 0, At, B0); PG8_MMA(0, 1, At, B1); PG8_BAR; PG8_SCHED;
            PG8_LDA(At, 0, 1); PG8_STAGE(PG8_SB(0, 0), b2, voffB); PG8_STAGE(PG8_SB(0, 1), b2 + hstepB, voffB); PG8_STAGE(PG8_SA(0, 0), a2, voffA);
            PG8_WAIT_V(8); PG8_WAIT_L(0); PG8_BAR; PG8_MMA(1, 0, At, B0); PG8_MMA(1, 1, At, B1); PG8_BAR; PG8_SCHED;
            PG8_LDB(B0, 1, 0); PG8_LDB(B1, 1, 1); PG8_SCHED; PG8_LDA(At, 1, 0); PG8_STAGE(PG8_SA(0, 1), a2 + hstepA, voffA);
            PG8_WAIT_V(8); PG8_WAIT_L(0); PG8_BAR; PG8_MMA(0, 0, At, B0); PG8_MMA(0, 1, At, B1); PG8_BAR; PG8_SCHED;
            PG8_LDA(At, 1, 1); PG8_STAGE(PG8_SB(1, 0), b3, voffB); PG8_STAGE(PG8_SB(1, 1), b3 + hstepB, voffB); PG8_STAGE(PG8_SA(1, 0), a3, voffA);
            PG8_WAIT_V(8); PG8_WAIT_L(0); PG8_BAR; PG8_MMA(1, 0, At, B0); PG8_MMA(1, 1, At, B1); PG8_BAR; PG8_SCHED;
            } else {
            PG8_LDB(B0, 0, 0); PG8_SCHED; PG8_LDA(At, 0, 0); PG8_STAGE(PG8_SA(1, 1), a1 + hstepA, voffA);
            PG8_WAIT_L(8); PG8_BAR; PG8_WAIT_L(0); PG8_MMA(0, 0, At, B0); PG8_BAR; PG8_SCHED;
            PG8_LDB(B1, 0, 1); PG8_STAGE(PG8_SB(0, 0), b2, voffB);
            PG8_BAR; PG8_WAIT_L(0); PG8_MMA(0, 1, At, B1); PG8_BAR;
            PG8_LDA(At, 0, 1); PG8_STAGE(PG8_SA(0, 0), a2, voffA);
            PG8_BAR; PG8_WAIT_L(0); PG8_MMA(1, 0, At, B0); PG8_BAR; PG8_SCHED;
            PG8_STAGE(PG8_SB(0, 1), b2 + hstepB, voffB);
            PG8_WAIT_V(6); PG8_BAR; PG8_MMA(1, 1, At, B1); PG8_BAR;
            PG8_LDB(B0, 1, 0); PG8_SCHED; PG8_LDA(At, 1, 0); PG8_STAGE(PG8_SA(0, 1), a2 + hstepA, voffA);
            PG8_WAIT_L(8); PG8_BAR; PG8_WAIT_L(0); PG8_MMA(0, 0, At, B0); PG8_BAR; PG8_SCHED;
            PG8_LDB(B1, 1, 1); PG8_STAGE(PG8_SB(1, 0), b3, voffB);
            PG8_BAR; PG8_WAIT_L(0); PG8_MMA(0, 1, At, B1); PG8_BAR;
            PG8_LDA(At, 1, 1); PG8_STAGE(PG8_SA(1, 0), a3, voffA);
            PG8_BAR; PG8_WAIT_L(0); PG8_MMA(1, 0, At, B0); PG8_BAR; PG8_SCHED;
            PG8_STAGE(PG8_SB(1, 1), b3 + hstepB, voffB);
            PG8_WAIT_V(6); PG8_BAR; PG8_MMA(1, 1, At, B1); PG8_BAR;
            }
        }
        if constexpr (ALIGN_EPI) { if (wr == 0) PG8_BAR; }
        E(acc, cur, wr, wc, fr, fq);
        if (!has_next) break;
#pragma unroll
        for (int a = 0; a < 2; ++a)
#pragma unroll
            for (int b = 0; b < 2; ++b)
#pragma unroll
                for (int m = 0; m < 4; ++m)
#pragma unroll
                    for (int n = 0; n < 2; ++n) acc[a][b][m][n] = (f32x4){0.f, 0.f, 0.f, 0.f};
        cur = nxt; ++ui;
        if constexpr (ALIGN_EPI) { if (wr == 1) PG8_BAR; }
    }
    PG8_WAIT_V(0);
    if constexpr (!ALIGN_EPI) { if (wr == 0) PG8_BAR; }
    PG8_BAR;
#undef PG8_SA
#undef PG8_SB
#undef PG8_STAGE
#undef PG8_LDA
#undef PG8_LDB
#undef PG8_MMA
#undef PG8_WAIT_V
#undef PG8_WAIT_L
#undef PG8_BAR
#undef PG8_SCHED
}
}

constexpr int NWAVES = 8;
constexpr int BATCH = 4, SEQ = 4096, D = 1024, FF = 4096, M = BATCH * SEQ;
constexpr int RH = 4, RDK = 256, RDV = 512, RIN = 2 * RH * RDK + 2 * RH * RDV  , RCH = 256  , RNC = SEQ / RCH  ;
constexpr int AH = 16, HD = 64;
constexpr float EPS = 1e-6f;
constexpr float LOG2E = 1.4426950408889634f;

constexpr size_t MiB = 1u << 20;
constexpr size_t WS_CTL = 0, CTL_ZERO_BYTES = 1 * MiB;
constexpr size_t WS_W = 1 * MiB;
constexpr size_t WS_WIN = WS_W, WS_WOUT = WS_W + 16 * MiB, WS_WUP = WS_W, WS_WDN = WS_W + 8 * MiB;
constexpr size_t WS_KM = 21 * MiB;
constexpr size_t WS_RN = 21 * MiB + 512 * 1024;
constexpr size_t WS_SQ = 22 * MiB;
constexpr size_t WS_SS = 23 * MiB;
constexpr size_t WS_BIG = 25 * MiB;
constexpr size_t WS_H = WS_BIG;
constexpr size_t WS_U = WS_BIG + 32 * MiB;
constexpr size_t WS_QT = WS_BIG + 32 * MiB, WS_KTK = WS_BIG + 64 * MiB, WS_P = WS_KTK  , WS_KF = WS_BIG + 96 * MiB, WS_VT = WS_BIG + 128 * MiB, WS_G = WS_BIG + 192 * MiB;
constexpr size_t WS_AQ = WS_BIG + 32 * MiB, WS_AK = WS_BIG + 64 * MiB, WS_AV = WS_BIG + 96 * MiB, WS_OB = WS_BIG + 128 * MiB  , WS_OB1 = WS_BIG + 160 * MiB  , WS_Y = WS_BIG + 192 * MiB;
constexpr size_t WS_END = WS_BIG + 256 * MiB;
constexpr int CW_TMO = 0, CW_BAR = 4096;

constexpr int RING_OFF = 0, RING_BYTES = 131072;
constexpr int LDSCTL_OFF = RING_BYTES, MISC_OFF = LDSCTL_OFF + 320;
constexpr int LDS_BYTES = 163840;

#define GAS __attribute__((address_space(1)))
#define LAS __attribute__((address_space(3)))
typedef unsigned short bf16;
typedef unsigned v4u __attribute__((ext_vector_type(4)));
typedef unsigned v2u __attribute__((ext_vector_type(2)));
typedef float f32x4 __attribute__((ext_vector_type(4)));
typedef GAS unsigned gu32;
#define RLX_AGENT __ATOMIC_RELAXED, __HIP_MEMORY_SCOPE_AGENT
#define LDS_WAIT() asm volatile("s_waitcnt lgkmcnt(0)" ::: "memory")
#define VM_WAIT() asm volatile("s_waitcnt vmcnt(0)" ::: "memory")
__device__ __forceinline__ unsigned f2bf(float f) { unsigned u = __builtin_bit_cast(unsigned, f); return (u + 0x7fffu + ((u >> 16) & 1u)) >> 16; }
__device__ __forceinline__ unsigned pk2(float lo, float hi) { return f2bf(lo) | (f2bf(hi) << 16); }
__device__ __forceinline__ float bflo(unsigned w) { return __builtin_bit_cast(float, w << 16); }
__device__ __forceinline__ float bfhi(unsigned w) { return __builtin_bit_cast(float, w & 0xffff0000u); }
__device__ __forceinline__ float wave_sum(float v) {
#pragma unroll
    for (int o = 1; o < 64; o <<= 1) v += __shfl_xor(v, o);
    return v;
}

namespace pg8 {
__device__ __forceinline__ float row16_sum(float v) {
    v += __builtin_bit_cast(float, __builtin_amdgcn_update_dpp(0, __builtin_bit_cast(int, v), 0xB1, 0xF, 0xF, true));
    v += __builtin_bit_cast(float, __builtin_amdgcn_update_dpp(0, __builtin_bit_cast(int, v), 0x4E, 0xF, 0xF, true));
    v += __builtin_bit_cast(float, __builtin_amdgcn_update_dpp(0, __builtin_bit_cast(int, v), 0x141, 0xF, 0xF, true));
    v += __builtin_bit_cast(float, __builtin_amdgcn_update_dpp(0, __builtin_bit_cast(int, v), 0x140, 0xF, 0xF, true));
    return v;
}
struct EpiRetIn {
    static constexpr bool PERM = true, KHOOK = false;
    bf16_t *QT, *KTK, *KF, *VT, *G; const PG8_LAS float* RN; PG8_LAS unsigned char* tsc;
    __device__ __forceinline__ void operator()(f32x4 (&acc)[2][2][4][2], const Unit& u, int wr, int wc, int fr, int fq) const {
        asm volatile("" : "+v"(fr), "+v"(fq));
        const float RL = 13.287712379549449f / 128.f, I2PI = 0.15915494309189535f;
        if (u.ty == 2) {
            bf16_t* base = G + (size_t)(u.pm * 256 + wr * 64 + fr) * 2048 + (u.pn - 8) * 256 + wc * 32 + 8 * fq;
#pragma unroll
            for (int ai = 0; ai < 2; ++ai)
#pragma unroll
                for (int m = 0; m < 4; ++m) { const float rn = RN[u.z * 256 + ai * 128 + wr * 64 + m * 16 + fr];
#pragma unroll
                    for (int bj = 0; bj < 2; ++bj) *(u32x4*)(base + (size_t)(ai * 128 + m * 16) * 2048 + bj * 128) = pack8(acc[ai][bj][m][0] * rn, acc[ai][bj][m][1] * rn); }
        } else if (u.ty == 4) {
            const int vt = u.pm, h = vt >> 1, half = vt & 1, b = u.pn >> 4, nc = u.pn & 15;
            bf16_t* base = VT + ((size_t)(((b * 4 + h) * 16 + nc) * 512 + half * 256 + wr * 64 + fr)) * 256 + wc * 32 + 8 * fq;
            f32x4 rc[2][2];
#pragma unroll
            for (int bj = 0; bj < 2; ++bj)
#pragma unroll
                for (int n = 0; n < 2; ++n) rc[bj][n] = *(const PG8_LAS f32x4*)(RN + u.z * 256 + bj * 128 + wc * 32 + 8 * fq + 4 * n);
#pragma unroll
            for (int ai = 0; ai < 2; ++ai)
#pragma unroll
                for (int m = 0; m < 4; ++m)
#pragma unroll
                    for (int bj = 0; bj < 2; ++bj) *(u32x4*)(base + (size_t)(ai * 128 + m * 16) * 256 + bj * 128) = pack8(acc[ai][bj][m][0] * rc[bj][0], acc[ai][bj][m][1] * rc[bj][1]);
        } else {
            const int h = u.pn & 3, b = u.pm >> 4;
            const float lg = __builtin_amdgcn_logf(1.0f - __builtin_amdgcn_exp2f(-5.0f - (float)h));
            float fi[2][4];
#pragma unroll
            for (int n = 0; n < 2; ++n)
#pragma unroll
                for (int j = 0; j < 4; ++j) fi[n][j] = __builtin_amdgcn_exp2f(-(float)(wc * 32 + 8 * fq + 4 * n + j) * RL) * I2PI;
            bf16_t* base = (u.ty == 0 ? QT : KTK) + (size_t)(b * 4 + h) * 4096 * 256 + wc * 32 + 8 * fq;
#pragma unroll
            for (int ai = 0; ai < 2; ++ai)
#pragma unroll
                for (int m = 0; m < 4; ++m) {
                    const int posi = (u.pm & 15) * 256 + ai * 128 + wr * 64 + m * 16 + fr, p = posi & 255; const float pos = (float)posi;
                    const float dec = ((u.ty == 0) ? __builtin_amdgcn_exp2f((float)p * lg) : 0.0625f * __builtin_amdgcn_exp2f(-(float)p * lg)) * RN[u.z * 256 + ai * 128 + wr * 64 + m * 16 + fr];
                    f32x4 y1[2], y2[2];
#pragma unroll
                    for (int n = 0; n < 2; ++n)
#pragma unroll
                        for (int j = 0; j < 4; ++j) {
                            const float rev = __builtin_amdgcn_fractf(pos * fi[n][j]); const float c = __builtin_amdgcn_cosf(rev), s = __builtin_amdgcn_sinf(rev);
                            const float x1 = acc[ai][0][m][n][j], x2 = acc[ai][1][m][n][j];
                            y1[n][j] = (x1 * c - x2 * s) * dec; y2[n][j] = (x1 * s + x2 * c) * dec; }
                    const u32x4 w1 = pack8(y1[0], y1[1]), w2 = pack8(y2[0], y2[1]);
                    *(u32x4*)(base + (size_t)posi * 256) = w1;
                    *(u32x4*)(base + (size_t)posi * 256 + 128) = w2;
                    if (u.ty == 1) {
                        PG8_LAS unsigned char* sc = tsc + (wr * 4 + wc) * 2048;
                        *(PG8_LAS u32x4*)(sc + fr * 64 + fq * 16) = w1; *(PG8_LAS u32x4*)(sc + 1024 + fr * 64 + fq * 16) = w2;
                        asm volatile("s_waitcnt lgkmcnt(0)" ::: "memory");
                        const int c = (fq & 1) * 16 + fr, o = fq >> 1; unsigned t1[4], t2[4];
#pragma unroll
                        for (int q = 0; q < 4; ++q) {
                            t1[q] = (unsigned)*(const PG8_LAS unsigned short*)(sc + (8 * o + 2 * q) * 64 + 2 * c) | ((unsigned)*(const PG8_LAS unsigned short*)(sc + (8 * o + 2 * q + 1) * 64 + 2 * c) << 16);
                            t2[q] = (unsigned)*(const PG8_LAS unsigned short*)(sc + 1024 + (8 * o + 2 * q) * 64 + 2 * c) | ((unsigned)*(const PG8_LAS unsigned short*)(sc + 1024 + (8 * o + 2 * q + 1) * 64 + 2 * c) << 16); }
                        bf16_t* kf = KF + ((size_t)(((b * 4 + h) * 16 + (u.pm & 15)) * 256 + wc * 32 + c)) * 256 + ai * 128 + wr * 64 + m * 16 + 8 * o;
                        *(u32x4*)kf = (u32x4){t1[0], t1[1], t1[2], t1[3]}; *(u32x4*)(kf + (size_t)128 * 256) = (u32x4){t2[0], t2[1], t2[2], t2[3]};
                        asm volatile("s_waitcnt lgkmcnt(0)" ::: "memory");
                    }
                    __builtin_amdgcn_sched_barrier(0);
                }
        }
    }
};
struct EpiMask {
    static constexpr bool PERM = true, KHOOK = false;
    bf16_t* P;
    __device__ __forceinline__ void operator()(f32x4 (&acc)[2][2][4][2], const Unit& u, int wr, int wc, int fr, int fq) const {
        asm volatile("" : "+v"(fr), "+v"(fq));
        bf16_t* base = P + ((size_t)u.z * 4096 + u.pm * 256 + wr * 64 + fr) * 256 + wc * 32 + 8 * fq;
#pragma unroll
        for (int ai = 0; ai < 2; ++ai)
#pragma unroll
            for (int m = 0; m < 4; ++m) { const int r = ai * 128 + wr * 64 + m * 16 + fr;
#pragma unroll
                for (int bj = 0; bj < 2; ++bj) { f32x4 v0 = acc[ai][bj][m][0], v1 = acc[ai][bj][m][1]; const int c0 = bj * 128 + wc * 32 + 8 * fq;
#pragma unroll
                    for (int j = 0; j < 4; ++j) { if (c0 + j > r) v0[j] = 0.f; if (c0 + 4 + j > r) v1[j] = 0.f; }
                    *(u32x4*)(base + (size_t)(ai * 128 + m * 16) * 256 + bj * 128) = pack8(v0, v1); } }
    }
};
struct EpiState {
    static constexpr bool PERM = true, KHOOK = false;
    bf16_t* ST;
    __device__ __forceinline__ void operator()(f32x4 (&acc)[2][2][4][2], const Unit& u, int wr, int wc, int fr, int fq) const {
        asm volatile("" : "+v"(fr), "+v"(fq));
        bf16_t* base = ST + ((size_t)u.z * 512 + u.pn * 256 + wr * 64 + fr) * 256 + wc * 32 + 8 * fq;
#pragma unroll
        for (int ai = 0; ai < 2; ++ai)
#pragma unroll
            for (int m = 0; m < 4; ++m)
#pragma unroll
                for (int bj = 0; bj < 2; ++bj) *(u32x4*)(base + (size_t)(ai * 128 + m * 16) * 256 + bj * 128) = pack8(acc[ai][bj][m][0], acc[ai][bj][m][1]);
    }
};
struct EpiMaskState {
    static constexpr bool PERM = true, KHOOK = false;
    EpiMask em; EpiState es;
    __device__ __forceinline__ void operator()(f32x4 (&acc)[2][2][4][2], const Unit& u, int wr, int wc, int fr, int fq) const { if (u.ty == 0) em(acc, u, wr, wc, fr, fq); else es(acc, u, wr, wc, fr, fq); }
};
struct EpiRetOut {
    static constexpr bool PERM = true, KHOOK = false;
    bf16_t* G; float* SS;
    __device__ __forceinline__ void operator()(f32x4 (&acc)[2][2][4][2], const Unit& u, int wr, int wc, int fr, int fq) const {
        asm volatile("" : "+v"(fr), "+v"(fq));
        const int h = u.z, half = u.pn;
        bf16_t* base = G + (size_t)(u.pm * 256 + wr * 64 + fr) * 2048 + h * 512 + half * 256 + wc * 32 + 8 * fq;
#pragma unroll
        for (int am = 0; am < 4; ++am) { const int ai = am >> 1;
            u32x4 gall[4][2];
#pragma unroll
            for (int m = 2 * (am & 1); m < 2 * (am & 1) + 2; ++m)
#pragma unroll
                for (int bj = 0; bj < 2; ++bj) gall[m][bj] = *(const u32x4*)(base + (size_t)(ai * 128 + m * 16) * 2048 + bj * 128);
            __builtin_amdgcn_sched_barrier(0);
#pragma unroll
            for (int m = 2 * (am & 1); m < 2 * (am & 1) + 2; ++m) {
                const int tok = u.pm * 256 + ai * 128 + wr * 64 + m * 16 + fr;
                float ss = 0.f;
#pragma unroll
                for (int bj = 0; bj < 2; ++bj)
#pragma unroll
                    for (int n = 0; n < 2; ++n) { const f32x4 x = acc[ai][bj][m][n]; ss += (x[0] * x[0] + x[1] * x[1]) + (x[2] * x[2] + x[3] * x[3]); }
                ss += __shfl_xor(ss, 16); ss += __shfl_xor(ss, 32);
                if (fq == 0) SS[((size_t)(tok * 4 + h) * 2 + half) * 4 + wc] = ss;
#pragma unroll
                for (int bj = 0; bj < 2; ++bj) {
                    bf16_t* p = base + (size_t)(ai * 128 + m * 16) * 2048 + bj * 128;
                    const u32x4 gw = gall[m][bj]; f32x4 v0 = acc[ai][bj][m][0], v1 = acc[ai][bj][m][1];
                    float gv[8] = {bflo(gw.x), bfhi(gw.x), bflo(gw.y), bfhi(gw.y), bflo(gw.z), bfhi(gw.z), bflo(gw.w), bfhi(gw.w)};
#pragma unroll
                    for (int j = 0; j < 4; ++j) { const float g0 = gv[j], g1 = gv[4 + j];
                        v0[j] *= g0 * __builtin_amdgcn_rcpf(1.0f + __builtin_amdgcn_exp2f(-g0 * 1.4426950408889634f));
                        v1[j] *= g1 * __builtin_amdgcn_rcpf(1.0f + __builtin_amdgcn_exp2f(-g1 * 1.4426950408889634f)); }
                    *(u32x4*)p = pack8(v0, v1); }
            }
        }
    }
};
#define PG8_RES_BODY(SCALE) \
        const size_t off0 = (size_t)(u.pm * 256 + wr * 64 + fr) * 1024 + u.pn * 256 + wc * 32 + 8 * fq; \
        _Pragma("unroll") for (int ai = 0; ai < 2; ++ai) { \
            u32x4 xw[4][2];     \
            _Pragma("unroll") for (int m = 0; m < 4; ++m) \
                _Pragma("unroll") for (int bj = 0; bj < 2; ++bj) xw[m][bj] = *(const u32x4*)(XB + off0 + (size_t)(ai * 128 + m * 16) * 1024 + bj * 128); \
            __builtin_amdgcn_sched_barrier(0); \
            _Pragma("unroll") for (int m = 0; m < 4; ++m) { const size_t off = off0 + (size_t)(ai * 128 + m * 16) * 1024; \
                float ss = 0.f; SCALE \
                _Pragma("unroll") for (int bj = 0; bj < 2; ++bj) { const u32x4 bw = xw[m][bj]; \
                    const f32x4 b0 = (f32x4){bflo(bw.x), bfhi(bw.x), bflo(bw.y), bfhi(bw.y)}, b1 = (f32x4){bflo(bw.z), bfhi(bw.z), bflo(bw.w), bfhi(bw.w)}; \
                    const f32x4 o0 = b0 + acc[ai][bj][m][0] * r3, o1 = b1 + acc[ai][bj][m][1] * r3; \
                    if (LAST) { *(f32x4*)(out + off + bj * 128) = o0; *(f32x4*)(out + off + bj * 128 + 4) = o1; } \
                    else { ss += ((o0[0] * o0[0] + o0[1] * o0[1]) + (o0[2] * o0[2] + o0[3] * o0[3])) + ((o1[0] * o1[0] + o1[1] * o1[1]) + (o1[2] * o1[2] + o1[3] * o1[3])); \
                        *(u32x4*)(XB + off + bj * 128) = pack8(o0, o1); } } \
                if (!LAST) { ss += __shfl_xor(ss, 16); ss += __shfl_xor(ss, 32); \
                    if (fq == 0) lsq[(ai * 128 + wr * 64 + m * 16 + fr) * 4 + wc] = ss; } \
                __builtin_amdgcn_sched_barrier(0); } } \
        if (!LAST) { asm volatile("s_waitcnt lgkmcnt(0)" ::: "memory"); __builtin_amdgcn_s_barrier(); asm volatile("" ::: "memory");     \
            const int t = (wr * 4 + wc) * 64 + fq * 16 + fr; if (t < 256) { const f32x4 p = *(const PG8_LAS f32x4*)(lsq + t * 4); SQ[(size_t)(u.pm * 256 + t) * 4 + u.pn] = (p[0] + p[1]) + (p[2] + p[3]); } }
template <bool LAST>
struct EpiRes {
    static constexpr bool PERM = true, KHOOK = false;
    bf16_t* XB; float* out; float* SQ; PG8_LAS float* lsq;
    __device__ __forceinline__ void operator()(f32x4 (&acc)[2][2][4][2], const Unit& u, int wr, int wc, int fr, int fq) const {
        asm volatile("" : "+v"(fr), "+v"(fq));
        PG8_RES_BODY(const float r3 = 1.0f;)
    }
};
struct EpiResH {
    static constexpr bool PERM = true, KHOOK = true, LAST = false;
    bf16_t* XB; float* out; float* SQ; PG8_LAS float* lsq; const PG8_LAS float* RAT;
    __device__ __forceinline__ void khook(f32x4 (&acc)[2][2][4][2], int hb, int wr, int) const {
        const int fr = lane_now() & 15;
#pragma unroll
        for (int ai = 0; ai < 2; ++ai)
#pragma unroll
            for (int m = 0; m < 4; ++m) { const float f = RAT[(hb - 1) * 256 + ai * 128 + wr * 64 + m * 16 + fr];
#pragma unroll
                for (int bj = 0; bj < 2; ++bj)
#pragma unroll
                    for (int n = 0; n < 2; ++n) acc[ai][bj][m][n] *= f;
                __builtin_amdgcn_sched_barrier(0); }
    }
    __device__ __forceinline__ void operator()(f32x4 (&acc)[2][2][4][2], const Unit& u, int wr, int wc, int fr, int fq) const {
        asm volatile("" : "+v"(fr), "+v"(fq));
        PG8_RES_BODY(const float r3 = RAT[3 * 256 + ai * 128 + wr * 64 + m * 16 + fr];)
    }
};
struct EpiUp {
    static constexpr bool PERM = true, KHOOK = false;
    bf16_t* U; const PG8_LAS float* R2;
    __device__ __forceinline__ void operator()(f32x4 (&acc)[2][2][4][2], const Unit& u, int wr, int wc, int fr, int fq) const {
        asm volatile("" : "+v"(fr), "+v"(fq));
        bf16_t* base = U + (size_t)(u.pm * 256 + wr * 64 + fr) * 4096 + u.pn * 256 + wc * 32 + 8 * fq;
#pragma unroll
        for (int ai = 0; ai < 2; ++ai)
#pragma unroll
            for (int m = 0; m < 4; ++m) {
                const float r2 = R2[u.z * 256 + ai * 128 + wr * 64 + m * 16 + fr];
#pragma unroll
                for (int bj = 0; bj < 2; ++bj) { f32x4 v0 = acc[ai][bj][m][0], v1 = acc[ai][bj][m][1];
#pragma unroll
                    for (int j = 0; j < 4; ++j) { const float a = __builtin_fmaxf(v0[j], 0.f), b = __builtin_fmaxf(v1[j], 0.f); v0[j] = a * a * r2; v1[j] = b * b * r2; }
                    *(u32x4*)(base + (size_t)(ai * 128 + m * 16) * 4096 + bj * 128) = pack8(v0, v1); } }
    }
};
template <bool MOBA>
struct EpiQKNorm {
    static constexpr bool PERM = true, KHOOK = false;
    bf16_t *Q, *K, *V; const float *qw, *kw; const PG8_LAS float* RN; bf16_t* KM; PG8_LAS float* cls;
    __device__ __forceinline__ void operator()(f32x4 (&acc)[2][2][4][2], const Unit& u, int wr, int wc, int fr, int fq) const {
        asm volatile("" : "+v"(fr), "+v"(fq));
        const int row0 = u.pm * 256 + wr * 64 + fr;
        float rnv[2][4];
#pragma unroll
        for (int ai = 0; ai < 2; ++ai)
#pragma unroll
            for (int m = 0; m < 4; ++m) rnv[ai][m] = RN[u.z * 256 + ai * 128 + wr * 64 + m * 16 + fr];
        if (u.pn >= 8) {
            bf16_t* base = V + (size_t)row0 * 1024 + (u.pn - 8) * 256 + wc * 32 + 8 * fq;
#pragma unroll
            for (int ai = 0; ai < 2; ++ai)
#pragma unroll
                for (int m = 0; m < 4; ++m) { const float rn = rnv[ai][m];
#pragma unroll
                    for (int bj = 0; bj < 2; ++bj) *(u32x4*)(base + (size_t)(ai * 128 + m * 16) * 1024 + bj * 128) = pack8(acc[ai][bj][m][0] * rn, acc[ai][bj][m][1] * rn); }
        } else {
            const bool isq = u.pn < 4; const float* w = isq ? qw : kw; const float sc = isq ? 0.125f * 1.4426950408889634f : 1.0f;
            f32x4 wv[2][2];
#pragma unroll
            for (int bj = 0; bj < 2; ++bj)
#pragma unroll
                for (int n = 0; n < 2; ++n) wv[bj][n] = *(const f32x4*)(w + 32 * bj + 8 * fq + 4 * n);
            bf16_t* base = (isq ? Q : K) + (size_t)row0 * 1024 + ((u.pn & 3) * 4 + wc) * 64 + 8 * fq;
#pragma unroll
            for (int ai = 0; ai < 2; ++ai)
#pragma unroll
                for (int m = 0; m < 4; ++m) {
                    float ss = 0.f; const float rn = rnv[ai][m];
#pragma unroll
                    for (int bj = 0; bj < 2; ++bj)
#pragma unroll
                        for (int n = 0; n < 2; ++n) { acc[ai][bj][m][n] *= rn; const f32x4 x = acc[ai][bj][m][n]; ss += (x[0] * x[0] + x[1] * x[1]) + (x[2] * x[2] + x[3] * x[3]); }
                    ss += __shfl_xor(ss, 16); ss += __shfl_xor(ss, 32);
                    const float r = __builtin_amdgcn_rsqf(ss * (1.0f / 64.0f) + 1e-6f) * sc;
#pragma unroll
                    for (int bj = 0; bj < 2; ++bj) { const f32x4 v0 = acc[ai][bj][m][0] * r * wv[bj][0], v1 = acc[ai][bj][m][1] * r * wv[bj][1];
                        *(u32x4*)(base + (size_t)(ai * 128 + m * 16) * 1024 + bj * 32) = pack8(v0, v1);
                        if constexpr (MOBA) { if (!isq) {
                            f32x4 s0 = v0, s1 = v1;
#pragma unroll
                            for (int j = 0; j < 4; ++j) { s0[j] = row16_sum(s0[j]); s1[j] = row16_sum(s1[j]); }
                            if (fr == 0) { PG8_LAS f32x4* p = (PG8_LAS f32x4*)(cls + (wr * 4 + wc) * 64 + bj * 32 + 8 * fq); p[0] = p[0] + s0; p[1] = p[1] + s1; } } } }
                }
            if constexpr (MOBA) { if (!isq) {
                asm volatile("s_waitcnt lgkmcnt(0)" ::: "memory"); __builtin_amdgcn_s_barrier(); asm volatile("" ::: "memory");
                const int t = (wr * 4 + wc) * 64 + fq * 16 + fr;
                if (t < 256) { const float sm = cls[t] + cls[256 + t];
                    KM[((size_t)((u.pm >> 4) * 64 + (u.pm & 15))) * 1024 + (u.pn & 3) * 256 + t] = (bf16_t)(cvt_pk_bf16(sm * (1.f / 256.f), 0.f) & 0xffffu);
                    cls[t] = 0.f; cls[256 + t] = 0.f; }
            } }
        }
    }
};

struct SchedPlain {
    const char* A; const char* Bt; int nM, nN, G, c; size_t ta, tb;
    __device__ __forceinline__ bool next(int i, Unit& u) const {
        const long L = (long)i * G + c; if (L >= (long)nM * nN) return false;
        int pm, pn; tile_of((int)L, nM, nN, pm, pn); u.pm = pm; u.pn = pn; u.ty = 0; u.z = i;
        u.a0 = A + (size_t)pm * ta; u.b0 = Bt + (size_t)pn * tb; u.a1 = u.a0; u.b1 = u.b0; return true;
    }
};
struct SchedRetIn {
    const char* H; const char* W; int G, c;
    __device__ __forceinline__ bool next(int i, Unit& u) const {
        const long L = (long)i * G + c; if (L >= 1536) return false;
        int pm, pn; u.z = i;
        if (L < 1024) { tile_of((int)L, 64, 16, pm, pn); u.ty = pn < 4 ? 0 : (pn < 8 ? 1 : 2);
            u.a0 = H + (size_t)pm * (256 * 1024 * 2); u.b0 = W + (size_t)(pn < 8 ? pn : pn + 8) * (256 * 1024 * 2); }
        else { tile_of((int)L - 1024, 8, 64, pm, pn); u.ty = 4;
            u.a0 = W + (size_t)(pm + 8) * (256 * 1024 * 2); u.b0 = H + (size_t)pn * (256 * 1024 * 2); }
        u.pm = pm; u.pn = pn; u.a1 = u.a0; u.b1 = u.b0; return true;
    }
};
struct SchedRetP {
    const char* QT; const char* KTK; int G, c;
    __device__ __forceinline__ bool next(int i, Unit& u) const {
        const long L = (long)i * G + c; if (L >= 256) return false;
        const int bh = (int)L >> 4, nc = (int)L & 15; u.z = bh; u.pm = nc; u.pn = 0; u.ty = 0;
        const size_t off = ((size_t)bh * 4096 + nc * 256) * 256 * 2; u.a0 = QT + off; u.b0 = KTK + off; u.a1 = u.a0; u.b1 = u.b0; return true;
    }
};
struct SchedRetPS {
    const char* QT; const char* KTK; const char* VT; const char* KF; int G, c;
    __device__ __forceinline__ bool next(int i, Unit& u) const {
        const long L = (long)i * G + c; if (L >= 768) return false;
        if (L < 256) { const int bh = (int)L >> 4, nc = (int)L & 15; u.z = bh; u.pm = nc; u.pn = 0; u.ty = 0;
            const size_t off = ((size_t)bh * 4096 + nc * 256) * 256 * 2; u.a0 = QT + off; u.b0 = KTK + off; }
        else { const int l2 = (int)L - 256, half = l2 & 1, nc = (l2 >> 1) & 15, bh = l2 >> 5; u.z = bh * 16 + nc; u.pn = half; u.pm = 0; u.ty = 1;
            u.a0 = VT + ((size_t)(bh * 16 + nc) * 512 + half * 256) * 256 * 2; u.b0 = KF + (size_t)(bh * 16 + nc) * 256 * 256 * 2; }
        u.a1 = u.a0; u.b1 = u.b0; return true;
    }
};
struct SchedRetO {
    const char* P; const char* QT; const char* VT; const char* ST; int G, c;
    __device__ __forceinline__ bool next(int i, Unit& u) const {
        const long L = (long)i * G + c; if (L >= 512) return false;
        const int half = (int)L & 1, nc = ((int)L >> 1) & 15, bh = (int)L >> 5;
        u.z = bh & 3; u.pn = half; u.pm = (bh >> 2) * 16 + nc; u.ty = 0;
        const size_t offa = ((size_t)bh * 4096 + nc * 256) * 256 * 2;
        u.a0 = P + offa; u.a1 = QT + offa;
        u.b0 = VT + ((size_t)(bh * 16 + nc) * 512 + half * 256) * 256 * 2; u.b1 = ST + ((size_t)(bh * 16 + nc) * 512 + half * 256) * 256 * 2; return true;
    }
};
}

namespace attn_body {
using bf16 = __hip_bfloat16;
using bf16x8 = __attribute__((ext_vector_type(8))) short;
using s16x4 = __attribute__((ext_vector_type(4))) short;
using f32x16 = __attribute__((ext_vector_type(16))) float;
using u32x4 = __attribute__((ext_vector_type(4))) unsigned;
constexpr int D = 64;
constexpr int NW = 8, QBLK = 32, QB = QBLK * NW, KVBLK = 64;
__device__ __forceinline__ int crow(int r, int hi) { return (r & 3) + 8 * (r >> 2) + 4 * hi; }
#define SBAR() __builtin_amdgcn_sched_barrier(0)
__device__ __forceinline__ void cmask(f32x16& p0, f32x16& p1, int jb, int qrel, int hi) {
  const float NEG = -INFINITY; int kb = 64 * jb + 4 * hi; asm volatile("" : "+v"(kb), "+v"(qrel));
  #pragma unroll
  for (int r = 0; r < 16; ++r) { int kv = kb + (r & 3) + 8 * (r >> 2); if (kv > qrel) p0[r] = NEG; if (kv + 32 > qrel) p1[r] = NEG; }
}
constexpr int NSLOT = 3, SLOTB = 8192;
constexpr int LDS_K = 0, LDS_V = NSLOT * SLOTB, LDS_WS = 2 * NSLOT * SLOTB, LDS_OST = LDS_WS + NW * 64 * 4, LDS_BYTES = LDS_OST + NW * 4096;
constexpr int LDS_TAB = 86016, TAB_N = 4096 + 256;
__device__ __forceinline__ void glds16(const void* gsrc, unsigned lds_dst) { unsigned keep;
  asm volatile("s_mov_b32 %0, m0\n\ts_mov_b32 m0, %2\n\ts_nop 0\n\tglobal_load_lds_dwordx4 %1, off\n\ts_mov_b32 m0, %0" : "=&s"(keep) : "v"(gsrc), "s"(lds_dst) : "memory"); }
__device__ __forceinline__ void glds16s(const void* sbase, unsigned voff, unsigned lds_dst) { unsigned keep;
  asm volatile("s_mov_b32 %0, m0\n\ts_mov_b32 m0, %3\n\ts_nop 4\n\tglobal_load_lds_dwordx4 %1, %2\n\ts_mov_b32 m0, %0" : "=&s"(keep) : "v"(voff), "s"(sbase), "s"(lds_dst) : "memory"); }
__device__ __forceinline__ float max3f(float a, float b, float c) { float r; asm("v_max3_f32 %0, %1, %2, %3" : "=v"(r) : "v"(a), "v"(b), "v"(c)); return r; }
__device__ __forceinline__ float max2f(float a, float b) { float r; asm("v_max_f32_e32 %0, %1, %2" : "=v"(r) : "v"(a), "v"(b)); return r; }
__device__ __forceinline__ float fadd_s(float a, float b) { float r; asm("v_add_f32_e32 %0, %1, %2" : "=v"(r) : "v"(a), "v"(b)); return r; }
__device__ __forceinline__ float fsub_s(float a, float b) { float r; asm("v_sub_f32_e32 %0, %1, %2" : "=v"(r) : "v"(a), "v"(b)); return r; }
typedef float f32x2_t __attribute__((ext_vector_type(2))); typedef __bf16 bf16x2_t __attribute__((ext_vector_type(2)));
__device__ __forceinline__ unsigned cvtpk_s(float lo, float hi) { f32x2_t v = {lo, hi}; bf16x2_t b = __builtin_convertvector(v, bf16x2_t); return __builtin_bit_cast(unsigned, b); }
#define WAIT_BAR(N) asm volatile("s_waitcnt vmcnt(" #N ") lgkmcnt(0)\n\ts_barrier" ::: "memory")

__device__ __forceinline__ void qkt(f32x16& p0, f32x16& p1, const char* Kslot, const bf16x8* qr, const f32x16& negm, int r32, int hi) {
  const char* kb = Kslot + hi * 1024 + r32 * 16;
  #pragma unroll
  for (int d0 = 0; d0 < 4; ++d0) {
    const bf16x8 b0 = *reinterpret_cast<const bf16x8*>(kb + d0 * 2048);
    const bf16x8 b1 = *reinterpret_cast<const bf16x8*>(kb + d0 * 2048 + 512);
    if (d0 == 0) { p0 = __builtin_amdgcn_mfma_f32_32x32x16_bf16(b0, qr[0], negm, 0, 0, 0); p1 = __builtin_amdgcn_mfma_f32_32x32x16_bf16(b1, qr[0], negm, 0, 0, 0); }
    else { p0 = __builtin_amdgcn_mfma_f32_32x32x16_bf16(b0, qr[d0], p0, 0, 0, 0); p1 = __builtin_amdgcn_mfma_f32_32x32x16_bf16(b1, qr[d0], p1, 0, 0, 0); } }
}
typedef __attribute__((address_space(3))) const char* lds_cptr;
typedef __attribute__((address_space(3))) const float* lds_fptr;
typedef short v4i16_t __attribute__((ext_vector_type(4)));
__device__ __forceinline__ void kload8(bf16x8* kf, lds_cptr kp) {
  kf[0] = *(const __attribute__((address_space(3))) bf16x8*)(kp);        kf[1] = *(const __attribute__((address_space(3))) bf16x8*)(kp + 512);
  kf[2] = *(const __attribute__((address_space(3))) bf16x8*)(kp + 2048); kf[3] = *(const __attribute__((address_space(3))) bf16x8*)(kp + 2560);
  kf[4] = *(const __attribute__((address_space(3))) bf16x8*)(kp + 4096); kf[5] = *(const __attribute__((address_space(3))) bf16x8*)(kp + 4608);
  kf[6] = *(const __attribute__((address_space(3))) bf16x8*)(kp + 6144); kf[7] = *(const __attribute__((address_space(3))) bf16x8*)(kp + 6656);
}
__device__ __forceinline__ void kload2(bf16x8* kf, lds_cptr kp, int j) { kf[2 * j] = *(const __attribute__((address_space(3))) bf16x8*)(kp + j * 2048); kf[2 * j + 1] = *(const __attribute__((address_space(3))) bf16x8*)(kp + j * 2048 + 512); }
__device__ __forceinline__ s16x4 vtr(lds_cptr p) { return __builtin_bit_cast(s16x4, __builtin_amdgcn_ds_read_tr16_b64_v4i16((__attribute__((address_space(3))) v4i16_t*)p)); }
__device__ __forceinline__ float rowmax(const f32x16& p0, const f32x16& p1) {
  float a = max3f(p0[0], p0[1], p1[0]), b = max3f(p0[2], p0[3], p1[1]); a = max3f(a, p1[2], p1[3]);
  #pragma unroll
  for (int r = 4; r < 16; r += 4) { a = max3f(a, p0[r], p0[r + 1]); b = max3f(b, p0[r + 2], p0[r + 3]); a = max3f(a, p1[r], p1[r + 1]); b = max3f(b, p1[r + 2], p1[r + 3]); }
  const float m = max2f(a, b);
  auto rr = __builtin_amdgcn_permlane32_swap(__float_as_uint(m), __float_as_uint(m), false, false);
  return max2f(__uint_as_float(rr[0]), __uint_as_float(rr[1]));
}
__device__ __forceinline__ void pv(f32x16* o, int vb, bf16x8 pa0, bf16x8 pa1, bf16x8 pa2, bf16x8 pa3) {
  #pragma unroll
  for (int d0 = 0; d0 < 2; ++d0) { s16x4 lo[4], hi[4];
    #pragma unroll
    for (int ks = 0; ks < 4; ++ks) {
      asm volatile("ds_read_b64_tr_b16 %0,%1 offset:%c2" : "=&v"(lo[ks]) : "v"(vb), "i"(d0 * 4096 + ks * 1024) : "memory");
      asm volatile("ds_read_b64_tr_b16 %0,%1 offset:%c2" : "=&v"(hi[ks]) : "v"(vb), "i"(d0 * 4096 + ks * 1024 + 512) : "memory"); }
    asm volatile("s_waitcnt lgkmcnt(0)" ::: "memory"); SBAR();
    #define PK(k) (bf16x8){lo[k][0], lo[k][1], lo[k][2], lo[k][3], hi[k][0], hi[k][1], hi[k][2], hi[k][3]}
    o[d0] = __builtin_amdgcn_mfma_f32_32x32x16_bf16(pa0, PK(0), o[d0], 0, 0, 0);
    o[d0] = __builtin_amdgcn_mfma_f32_32x32x16_bf16(pa1, PK(1), o[d0], 0, 0, 0);
    o[d0] = __builtin_amdgcn_mfma_f32_32x32x16_bf16(pa2, PK(2), o[d0], 0, 0, 0);
    o[d0] = __builtin_amdgcn_mfma_f32_32x32x16_bf16(pa3, PK(3), o[d0], 0, 0, 0);
    #undef PK
  }
}
template <int GSZ> __device__ __forceinline__ void addbias(f32x16& p0, f32x16& p1, lds_fptr tab, int dq) {
  const lds_fptr tp = tab + (dq + 256 - 64);
  asm volatile("s_waitcnt lgkmcnt(0)" ::: "memory");
  #pragma unroll
  for (int g = 0; g < 16 / GSZ; ++g) {
    float a0[GSZ], a1[GSZ];
    #pragma unroll
    for (int i = 0; i < GSZ; ++i) { const int r = GSZ * g + i, off = (r & 3) + 8 * (r >> 2); a0[i] = tp[64 - off]; a1[i] = tp[32 - off]; }
    asm volatile("s_waitcnt lgkmcnt(0)" ::: "memory");
    #pragma unroll
    for (int i = 0; i < GSZ; ++i) { const int r = GSZ * g + i; p0[r] = fadd_s(p0[r], a0[i]); p1[r] = fadd_s(p1[r], a1[i]); }
    SBAR(); }
}

__device__ __forceinline__ void addbias_far(f32x16& p0, f32x16& p1, float subc) {
  #pragma unroll
  for (int r = 0; r < 16; ++r) { p0[r] = fsub_s(p0[r], subc); p1[r] = fsub_s(p1[r], subc); }
}
#define ATTN_STORE16(p, v) (*(u32x4*)(p) = (v))
template<int MODE, int THRL, int OP> __device__ __forceinline__ void attn_unit(int b, int qb, const bf16* Q, int qc, const bf16* __restrict__ K, int kc, const bf16* __restrict__ V, int vc,
                                                                      bf16* O, int oc, const bf16* KM, char* shm, const int wid) {
  constexpr int qp = 1024, kp = 1024, vp = 1024, op = OP, kmp = 1024;
  const int lane = lane_now(), r32 = lane & 31, hi = lane >> 5;
  const long rowbase = (long)b * SEQ; const int q0 = qb * QB;
  const bf16* Qw = Q + (rowbase + q0 + wid * QBLK) * qp + qc;
  const bf16* Kh = K + rowbase * kp + kc, *Vh = V + rowbase * vp + vc;
  const unsigned lds0 = (unsigned)(uintptr_t)shm;
  float* wsf = (float*)(shm + LDS_WS) + wid * 64;
  const lds_fptr tab = (lds_fptr)(lds_cptr)shm + LDS_TAB / 4;
  const unsigned koff = (unsigned)(lane * kp + wid * 8) * 2u;
  const unsigned voff = (unsigned)((16 * (wid & 3) + (lane >> 2)) * vp + (wid >> 2) * 32 + (lane & 3) * 8) * 2u;
  const unsigned kdst = lds0 + LDS_K + wid * 1024, vdst = lds0 + LDS_V + wid * 1024;
  #define DMA_K(t, slot) glds16s(Kh + (long)(t) * KVBLK * kp, koff, (unsigned)__builtin_amdgcn_readfirstlane(kdst + (slot)))
  #define DMA_V(t, slot) glds16s(Vh + (long)(t) * KVBLK * vp, voff, (unsigned)__builtin_amdgcn_readfirstlane(vdst + (slot)))
  const int vb0 = (int)(lds0 + LDS_V) + ((lane >> 4) & 1) * 32 + (lane & 3) * 8 + (4 * hi + ((lane & 15) >> 2)) * 64;
  const char* Kbase = shm + LDS_K; bf16x8 kf[8];
  const lds_cptr shm3 = (lds_cptr)shm; const lds_cptr kp0 = shm3 + LDS_K + hi * 1024 + r32 * 16; const lds_cptr vp0 = shm3 + LDS_V + ((lane >> 4) & 1) * 32 + (lane & 3) * 8 + (4 * hi + ((lane & 15) >> 2)) * 64;
  const int NT = (q0 + QB) / KVBLK;
  bf16x8 qr[4];
  #pragma unroll
  for (int d0 = 0; d0 < 4; ++d0) qr[d0] = *reinterpret_cast<const bf16x8*>(&Qw[(long)r32 * qp + d0 * 16 + hi * 8]);
  unsigned selmask = 0xffffffffu;
  if constexpr (MODE == 1) {
    glds16s(KM, (unsigned)(lane * kmp + wid * 8) * 2u, (unsigned)__builtin_amdgcn_readfirstlane(kdst));
    WAIT_BAR(0);
    f32x16 g0, g1; { const f32x16 z = f32x16{}; qkt(g0, g1, Kbase, qr, z, r32, hi); }
    asm volatile("s_nop 15\n\ts_nop 7" : "+v"(g0), "+v"(g1));
    float gg[16];
    #pragma unroll
    for (int r = 0; r < 8; ++r) { const float own = g0[r], oth = __shfl_xor(own, 32); const float lo = hi ? oth : own, hh = hi ? own : oth;
      gg[(r & 3) + 8 * (r >> 2)] = lo; gg[4 + (r & 3) + 8 * (r >> 2)] = hh; }
    #pragma unroll
    for (int n = 0; n < 16; ++n) gg[n] = (n < qb) ? gg[n] : -INFINITY;
    selmask = 0u;
    #pragma unroll
    for (int n = 0; n < 16; ++n) { int cnt = 0;
      #pragma unroll
      for (int m2 = 0; m2 < 16; ++m2) { if (m2 == n) continue; cnt += (gg[m2] > gg[n] || (gg[m2] == gg[n] && m2 < n)) ? 1 : 0; }
      const unsigned bit = (n < qb && cnt < 3) ? 1u : 0u; selmask |= bit << n; }
    asm volatile("s_waitcnt lgkmcnt(0)\n\ts_barrier" ::: "memory");
  }
  DMA_K(0, 0); DMA_V(0, 0); DMA_K(1, SLOTB);
  float mhat = 0.f, l_reg = 0.f; f32x16 o[2]; o[0] = f32x16{}; o[1] = f32x16{}; f32x16 negm = f32x16{}; asm volatile("" : "+v"(negm));
  const int qrel = wid * QBLK + r32;
  const int dq0 = q0 + qrel - 4 * hi;
  #define CMASK(P0, P1, t) do { int jb_ = (t) - (NT - 4); if (jb_ >= 0) cmask(P0, P1, jb_, qrel, hi); } while (0)
  #define BIAS(P0, P1, t) do { \
      if (MODE == 1) { if ((t) < NT - 4) { if (!((selmask >> ((t) >> 2)) & 1u)) { _Pragma("unroll") for (int r = 0; r < 16; ++r) { P0[r] = fsub_s(P0[r], 4096.f); P1[r] = fsub_s(P1[r], 4096.f); } } } } \
      if (64 * (t) + 853 > q0 + wid * QBLK) addbias<8>(P0, P1, tab, dq0 - 64 * (t)); } while (0)
  bool resc = false;
  #define START(P0, P1) do { const float rm = rowmax(P0, P1); resc = false; \
    { const float dl = rm; mhat = fadd_s(mhat, dl); \
      _Pragma("unroll") for (int r = 0; r < 16; ++r) { P0[r] = fsub_s(P0[r], dl); P1[r] = fsub_s(P1[r], dl); } \
      _Pragma("unroll") for (int r = 0; r < 16; ++r) negm[r] = -mhat; asm volatile("" : "+v"(negm)); } \
    _Pragma("unroll") for (int r = 0; r < 16; ++r) P0[r] = __builtin_amdgcn_exp2f(P0[r]); } while (0)
  #define RESC() do { if (resc) { asm volatile("s_waitcnt lgkmcnt(0)" ::: "memory"); \
      _Pragma("unroll") for (int d_ = 0; d_ < 2; ++d_) _Pragma("unroll") for (int r = 0; r < 16; ++r) o[d_][r] *= wsf[crow(r, hi)]; } } while (0)
  f32x16 pA0, pA1, pB0, pB1;
  int sl_prev = 0, sl_cur = 0, sl_next = SLOTB;
  #define ROT() do { sl_prev = sl_cur; sl_cur = sl_next; sl_next = (sl_next == (NSLOT - 1) * SLOTB) ? 0 : sl_next + SLOTB; } while (0)
  DMA_K(2, 2 * SLOTB);
  WAIT_BAR(3);
  qkt(pA0, pA1, Kbase, qr, negm, r32, hi); asm volatile("s_nop 15\n\ts_nop 7" : "+v"(pA0), "+v"(pA1)); BIAS(pA0, pA1, 0); CMASK(pA0, pA1, 0);
  START(pA0, pA1);
  _Pragma("unroll") for (int r = 0; r < 16; ++r) pA1[r] = __builtin_amdgcn_exp2f(pA1[r]);
  WAIT_BAR(0);
  DMA_K(3, 0); DMA_V(1, SLOTB);
  ROT();
  kload8(kf, kp0 + sl_cur);
  WAIT_BAR(2);
  s16x4 vlo[8], vhi[8]; u32x4 pw0, pw1, pw2, pw3;
  #define PKW(P, B) cvtpk_s(P[B], P[B + 1])
  #define PAF(k) __builtin_bit_cast(bf16x8, pw##k)
  #define VFR(i) (bf16x8){vlo[i][0], vlo[i][1], vlo[i][2], vlo[i][3], vhi[i][0], vhi[i][1], vhi[i][2], vhi[i][3]}
  #define PIN(x) asm volatile("" : "+v"(x))
  #define MX3(a, b, c) __builtin_fmaxf(__builtin_fmaxf((a), (b)), (c))
  #define GAPA(MF, A0, A1, A2, A3, W0, W1, PW) do { MF; sacc += A0; sacc += A1; sacc += A2; sacc += A3; PIN(sacc); W0; W1; PIN(PW); SBAR(); } while (0)
  #define EX(v) __builtin_amdgcn_exp2f(v)
  #define GAPB(MF, X, B) do { MF; X[B] = EX(X[B]); X[B + 1] = EX(X[B + 1]); X[B + 2] = EX(X[B + 2]); X[B + 3] = EX(X[B + 3]); PIN(X); SBAR(); } while (0)
  #define VRD(i) do { vlo[i] = vtr(vp_ + (((i) >> 2) * 4096 + ((i) & 3) * 1024)); vhi[i] = vtr(vp_ + (((i) >> 2) * 4096 + ((i) & 3) * 1024 + 512)); } while (0)
  #define KRD(G, j) do { if (G) { kload2(kf, kp0 + sl_next, j); SBAR(); } } while (0)
  #define STEP(C0, C1, P0, P1, t, GK, GV, GL) do { SBAR(); \
    const lds_cptr vp_ = vp0 + sl_prev; \
    VRD(0); SBAR(); float sacc = (P0[0] + P0[1]); \
    GAPA(C0 = __builtin_amdgcn_mfma_f32_32x32x16_bf16(kf[0], qr[0], negm, 0, 0, 0), P0[2], P0[3], P0[4], P0[5],     pw0[0] = PKW(P0, 0), pw0[1] = PKW(P0, 2), pw0); \
    VRD(4); SBAR(); GAPA(C1 = __builtin_amdgcn_mfma_f32_32x32x16_bf16(kf[1], qr[0], negm, 0, 0, 0), P0[6], P0[7], P0[8], P0[9],     pw0[2] = PKW(P0, 4), pw0[3] = PKW(P0, 6), pw0); \
    VRD(1); SBAR(); GAPA(C0 = __builtin_amdgcn_mfma_f32_32x32x16_bf16(kf[2], qr[1], C0, 0, 0, 0),   P0[10], P0[11], P0[12], P0[13], pw1[0] = PKW(P0, 8), pw1[1] = PKW(P0, 10), pw1); \
    VRD(5); SBAR(); GAPA(C1 = __builtin_amdgcn_mfma_f32_32x32x16_bf16(kf[3], qr[1], C1, 0, 0, 0),   P0[14], P0[15], P1[0], P1[1],   pw1[2] = PKW(P0, 12), pw1[3] = PKW(P0, 14), pw1); \
    VRD(2); SBAR(); GAPA(C0 = __builtin_amdgcn_mfma_f32_32x32x16_bf16(kf[4], qr[2], C0, 0, 0, 0),   P1[2], P1[3], P1[4], P1[5],     pw2[0] = PKW(P1, 0), pw2[1] = PKW(P1, 2), pw2); \
    VRD(6); SBAR(); GAPA(C1 = __builtin_amdgcn_mfma_f32_32x32x16_bf16(kf[5], qr[2], C1, 0, 0, 0),   P1[6], P1[7], P1[8], P1[9],     pw2[2] = PKW(P1, 4), pw2[3] = PKW(P1, 6), pw2); \
    VRD(3); SBAR(); GAPA(C0 = __builtin_amdgcn_mfma_f32_32x32x16_bf16(kf[6], qr[3], C0, 0, 0, 0),   P1[10], P1[11], P1[12], P1[13], pw3[0] = PKW(P1, 8), pw3[1] = PKW(P1, 10), pw3); \
    VRD(7); SBAR(); GAPA(C1 = __builtin_amdgcn_mfma_f32_32x32x16_bf16(kf[7], qr[3], C1, 0, 0, 0),   P1[14], P1[15], 0.f, 0.f,       pw3[2] = PKW(P1, 12), pw3[3] = PKW(P1, 14), pw3); \
    l_reg += sacc; \
    if (GK) { DMA_K((t) + 3, sl_cur); } if (GV) { DMA_V((t) + 1, sl_next); } \
    asm volatile("s_nop 15\n\ts_nop 3" : "+v"(C0), "+v"(C1)); BIAS(C0, C1, t); \
    CMASK(C0, C1, t); \
    { float a = MX3(C0[0], C0[1], C1[0]), b = MX3(C0[2], C0[3], C1[1]); a = MX3(a, C1[2], C1[3]); \
      _Pragma("unroll") for (int r = 4; r < 16; r += 4) { a = MX3(a, C0[r], C0[r + 1]); b = MX3(b, C0[r + 2], C0[r + 3]); a = MX3(a, C1[r], C1[r + 1]); b = MX3(b, C1[r + 2], C1[r + 3]); } \
      float rm = __builtin_fmaxf(a, b); { auto rr = __builtin_amdgcn_permlane32_swap(__float_as_uint(rm), __float_as_uint(rm), false, false); rm = __builtin_fmaxf(__uint_as_float(rr[0]), __uint_as_float(rr[1])); } \
      resc = false; \
      if (__builtin_expect(__any(rm > (float)THRL), 0)) { const float dl = __builtin_fmaxf(rm, 0.f); mhat += dl; \
        _Pragma("unroll") for (int r = 0; r < 16; ++r) { C0[r] -= dl; C1[r] -= dl; } \
        _Pragma("unroll") for (int r = 0; r < 16; ++r) negm[r] = -mhat; asm volatile("" : "+v"(negm)); \
        const float f = __builtin_amdgcn_exp2f(-dl); l_reg *= f; if (hi == 0) wsf[r32] = f; resc = true; } } \
    SBAR(); \
    GAPB(o[0] = __builtin_amdgcn_mfma_f32_32x32x16_bf16(PAF(0), VFR(0), o[0], 0, 0, 0), C0, 0); \
    GAPB(o[1] = __builtin_amdgcn_mfma_f32_32x32x16_bf16(PAF(0), VFR(4), o[1], 0, 0, 0), C0, 4); \
    KRD(GL, 0); GAPB(o[0] = __builtin_amdgcn_mfma_f32_32x32x16_bf16(PAF(1), VFR(1), o[0], 0, 0, 0), C0, 8); \
    KRD(GL, 1); GAPB(o[1] = __builtin_amdgcn_mfma_f32_32x32x16_bf16(PAF(1), VFR(5), o[1], 0, 0, 0), C0, 12); \
    KRD(GL, 2); GAPB(o[0] = __builtin_amdgcn_mfma_f32_32x32x16_bf16(PAF(2), VFR(2), o[0], 0, 0, 0), C1, 0); \
    KRD(GL, 3); GAPB(o[1] = __builtin_amdgcn_mfma_f32_32x32x16_bf16(PAF(2), VFR(6), o[1], 0, 0, 0), C1, 4); \
    GAPB(o[0] = __builtin_amdgcn_mfma_f32_32x32x16_bf16(PAF(3), VFR(3), o[0], 0, 0, 0), C1, 8); \
    GAPB(o[1] = __builtin_amdgcn_mfma_f32_32x32x16_bf16(PAF(3), VFR(7), o[1], 0, 0, 0), C1, 12); \
    } while (0)
  int t = 1;
  #undef CMASK
  #define CMASK(P0, P1, t) do {} while (0)
  for (; t + 5 < NT; t += 2) {
    STEP(pB0, pB1, pA0, pA1, t, true, true, true);     WAIT_BAR(2); RESC(); ROT();
    STEP(pA0, pA1, pB0, pB1, t + 1, true, true, true); WAIT_BAR(2); RESC(); ROT();
  }
  #undef CMASK
  #define CMASK(P0, P1, t) do { int jb_ = (t) - (NT - 4); if (jb_ >= 0) cmask(P0, P1, jb_, qrel, hi); } while (0)
  #define ENDW(tt) do { if ((tt) + 3 < NT) { WAIT_BAR(2); } else if ((tt) + 2 < NT) { WAIT_BAR(1); } else { WAIT_BAR(0); } } while (0)
  for (; t + 1 < NT; t += 2) {
    STEP(pB0, pB1, pA0, pA1, t, (t + 3 < NT), (t + 1 < NT), (t + 1 < NT));     ENDW(t);     RESC(); ROT();
    STEP(pA0, pA1, pB0, pB1, t + 1, (t + 4 < NT), (t + 2 < NT), (t + 2 < NT)); ENDW(t + 1); RESC(); ROT();
  }
  STEP(pB0, pB1, pA0, pA1, NT - 1, false, false, false); RESC();
  { float sacc = pB0[0] + pB0[1]; _Pragma("unroll") for (int r = 2; r < 16; ++r) sacc += pB0[r]; _Pragma("unroll") for (int r = 0; r < 16; ++r) sacc += pB1[r]; l_reg += sacc;
    pw0 = (u32x4){PKW(pB0, 0), PKW(pB0, 2), PKW(pB0, 4), PKW(pB0, 6)}; pw1 = (u32x4){PKW(pB0, 8), PKW(pB0, 10), PKW(pB0, 12), PKW(pB0, 14)}; pw2 = (u32x4){PKW(pB1, 0), PKW(pB1, 2), PKW(pB1, 4), PKW(pB1, 6)}; pw3 = (u32x4){PKW(pB1, 8), PKW(pB1, 10), PKW(pB1, 12), PKW(pB1, 14)};
    SBAR(); pv(o, vb0 + sl_cur, PAF(0), PAF(1), PAF(2), PAF(3)); }
  #undef PKW
  #undef PAF
  #undef VFR
  #undef PIN
  #undef MX3
  #undef GAPA
  #undef GAPB
  #undef EX
  #undef VRD
  #undef KRD
  #undef STEP
  #undef ENDW
  { auto rr = __builtin_amdgcn_permlane32_swap(__float_as_uint(l_reg), __float_as_uint(l_reg), false, false); l_reg = __uint_as_float(rr[0]) + __uint_as_float(rr[1]); }
  if (hi == 0) wsf[32 + r32] = l_reg; asm volatile("s_waitcnt lgkmcnt(0)" ::: "memory");
  float rli[16];
  #pragma unroll
  for (int r = 0; r < 16; ++r) rli[r] = __builtin_amdgcn_rcpf(wsf[32 + crow(r, hi)]);
  bf16* Ow = O + (rowbase + q0 + wid * QBLK) * op + oc;
  { bf16* stg = (bf16*)(shm + LDS_OST) + wid * 2048;
    #pragma unroll
    for (int r = 0; r < 16; ++r) { const int orow = crow(r, hi);
      #pragma unroll
      for (int d0 = 0; d0 < 2; ++d0) stg[orow * 64 + d0 * 32 + r32] = __float2bfloat16(o[d0][r] * rli[r]); }
    asm volatile("s_waitcnt lgkmcnt(0)" ::: "memory");
    #pragma unroll
    for (int i = 0; i < 4; ++i) { const int row = i * 8 + (lane >> 3), ch = lane & 7; const u32x4 v = *(const u32x4*)(stg + row * 64 + ch * 8); ATTN_STORE16(Ow + (long)row * op + ch * 8, v); } }
  asm volatile("s_waitcnt lgkmcnt(0)\n\ts_barrier" ::: "memory");
  #undef DMA_K
  #undef DMA_V
  #undef CMASK
  #undef BIAS
  #undef START
  #undef RESC
  #undef ROT
}
constexpr int V2_K = 0, V2_V = 24576, V2_WS = 73728, V2_Q = 75776, V2_TAB = 110592;
template<int THRL> __device__ __forceinline__ void attn_unit_v128(int b, int qb, const bf16* Q, int qc, const bf16* __restrict__ K, int kc, const bf16* __restrict__ V, int vc,
                                                                 bf16* O, int oc, char* shm, const int wid) {
  constexpr int MODE = 0; constexpr int qp = 1024, kp = 1024, vp = 1024, op = 2048;
  const int lane = lane_now(), r32 = lane & 31, hi = lane >> 5;
  const long rowbase = (long)b * SEQ; const int q0 = qb * QB;
  const bf16* Qw = Q + (rowbase + q0 + wid * QBLK) * qp + qc;
  const bf16* Kh = K + rowbase * kp + kc, *Vh = V + rowbase * vp + vc;
  const unsigned lds0 = (unsigned)(uintptr_t)shm;
  float* wsf = (float*)(shm + V2_WS) + wid * 64;
  const lds_fptr tab = (lds_fptr)(lds_cptr)shm + V2_TAB / 4;
  const unsigned koff = (unsigned)(lane * kp + wid * 8) * 2u;
  const unsigned voff = (unsigned)((16 * (wid & 3) + (lane >> 2)) * vp + (wid >> 2) * 32 + (lane & 3) * 8) * 2u;
  const unsigned kdst = lds0 + V2_K + wid * 1024, vdst = lds0 + V2_V + wid * 1024;
  #define DMA_K(t, slot) glds16s(Kh + (long)(t) * KVBLK * kp, koff, (unsigned)__builtin_amdgcn_readfirstlane(kdst + (slot)))
  #define DMA_V(t, slot) do { glds16s(Vh + (long)(t) * KVBLK * vp, voff, (unsigned)__builtin_amdgcn_readfirstlane(vdst + 2 * (slot))); glds16s(Vh + (long)(t) * KVBLK * vp, voff + 128u, (unsigned)__builtin_amdgcn_readfirstlane(vdst + 2 * (slot) + 8192)); } while (0)
  const int vb0 = (int)(lds0 + V2_V) + ((lane >> 4) & 1) * 32 + (lane & 3) * 8 + (4 * hi + ((lane & 15) >> 2)) * 64;
  const char* Kbase = shm + V2_K; bf16x8 kf[8];
  const lds_cptr shm3 = (lds_cptr)shm; const lds_cptr kp0 = shm3 + V2_K + hi * 1024 + r32 * 16; const lds_cptr vp0 = shm3 + V2_V + ((lane >> 4) & 1) * 32 + (lane & 3) * 8 + (4 * hi + ((lane & 15) >> 2)) * 64;
  const int NT = (q0 + QB) / KVBLK;
  bf16x8 qr[4];
  #pragma unroll
  for (int d0 = 0; d0 < 4; ++d0) qr[d0] = *reinterpret_cast<const bf16x8*>(&Qw[(long)r32 * qp + d0 * 16 + hi * 8]);
  typedef __attribute__((address_space(3))) bf16x8* lds_qptr; const lds_qptr qlds = (lds_qptr)(shm3 + V2_Q + wid * 4096 + lane * 16);
  DMA_K(0, 0); DMA_V(0, 0); DMA_K(1, SLOTB);
  float mhat = 0.f, l_reg = 0.f; f32x16 o[4]; o[0] = f32x16{}; o[1] = f32x16{}; o[2] = f32x16{}; o[3] = f32x16{}; const f32x16 negm = f32x16{};
  const int qrel = wid * QBLK + r32;
  const int dq0 = q0 + qrel - 4 * hi;
  #define CMASK(P0, P1, t) do { int jb_ = (t) - (NT - 4); if (jb_ >= 0) cmask(P0, P1, jb_, qrel, hi); } while (0)
  #define BIAS(P0, P1, t) do { if (64 * (t) + 853 > q0 + wid * QBLK) addbias<8>(P0, P1, tab, dq0 - 64 * (t)); addbias_far(P0, P1, mhat); } while (0)
  bool resc = false;
  #define START(P0, P1) do { const float rm = rowmax(P0, P1); resc = false; \
    { const float dl = rm; mhat = fadd_s(mhat, dl); \
      _Pragma("unroll") for (int r = 0; r < 16; ++r) { P0[r] = fsub_s(P0[r], dl); P1[r] = fsub_s(P1[r], dl); } \
      } \
    _Pragma("unroll") for (int r = 0; r < 16; ++r) P0[r] = __builtin_amdgcn_exp2f(P0[r]); } while (0)
  #define RESC() do { if (resc) { asm volatile("s_waitcnt lgkmcnt(0)" ::: "memory"); \
      _Pragma("unroll") for (int d_ = 0; d_ < 4; ++d_) _Pragma("unroll") for (int r = 0; r < 16; ++r) o[d_][r] *= wsf[crow(r, hi)]; } } while (0)
  f32x16 pA0, pA1, pB0, pB1;
  int sl_prev = 0, sl_cur = 0, sl_next = SLOTB;
  #define ROT() do { sl_prev = sl_cur; sl_cur = sl_next; sl_next = (sl_next == (NSLOT - 1) * SLOTB) ? 0 : sl_next + SLOTB; } while (0)
  DMA_K(2, 2 * SLOTB);
  WAIT_BAR(4);
  qkt(pA0, pA1, Kbase, qr, negm, r32, hi); asm volatile("s_nop 15\n\ts_nop 7" : "+v"(pA0), "+v"(pA1)); BIAS(pA0, pA1, 0); CMASK(pA0, pA1, 0);
  START(pA0, pA1);
  _Pragma("unroll") for (int r = 0; r < 16; ++r) pA1[r] = __builtin_amdgcn_exp2f(pA1[r]);
  _Pragma("unroll") for (int d0 = 0; d0 < 4; ++d0) qlds[64 * d0] = qr[d0];
  WAIT_BAR(0);
  DMA_K(3, 0); DMA_V(1, SLOTB);
  ROT();
  kload8(kf, kp0 + sl_cur);
  WAIT_BAR(3);
  s16x4 vlo[8], vhi[8]; u32x4 pw0, pw1, pw2, pw3;
  #define PKW(P, B) cvtpk_s(P[B], P[B + 1])
  #define PAF(k) __builtin_bit_cast(bf16x8, pw##k)
  #define VFR(i) (bf16x8){vlo[i][0], vlo[i][1], vlo[i][2], vlo[i][3], vhi[i][0], vhi[i][1], vhi[i][2], vhi[i][3]}
  #define PIN(x) asm volatile("" : "+v"(x))
  #define MX3(a, b, c) __builtin_fmaxf(__builtin_fmaxf((a), (b)), (c))
  #define GAPA(MF, A0, A1, A2, A3, W0, W1, PW) do { MF; sacc += A0; sacc += A1; sacc += A2; sacc += A3; PIN(sacc); W0; W1; PIN(PW); SBAR(); } while (0)
  #define EX(v) __builtin_amdgcn_exp2f(v)
  #define GAPB(MF, X, B) do { MF; X[B] = EX(X[B]); X[B + 1] = EX(X[B + 1]); X[B + 2] = EX(X[B + 2]); X[B + 3] = EX(X[B + 3]); PIN(X); SBAR(); } while (0)
  #define VRD(i) do { vlo[i] = vtr(vp_ + (((i) >> 2) * 4096 + ((i) & 3) * 1024)); vhi[i] = vtr(vp_ + (((i) >> 2) * 4096 + ((i) & 3) * 1024 + 512)); } while (0)
  #define VRD2(i) do { vlo[i] = vtr(vp_ + (8192 + ((i) >> 2) * 4096 + ((i) & 3) * 1024)); vhi[i] = vtr(vp_ + (8192 + ((i) >> 2) * 4096 + ((i) & 3) * 1024 + 512)); SBAR(); } while (0)
  #define GAPB2(MF, X, B) do { MF; X[B] = EX(X[B]); X[B + 1] = EX(X[B + 1]); PIN(X); SBAR(); } while (0)
  #define KRD(G, j) do { if (G) { kload2(kf, kp0 + sl_next, j); SBAR(); } } while (0)
  #define STEP(C0, C1, P0, P1, t, GK, GV, GL) do { SBAR(); \
    const lds_cptr vp_ = vp0 + 2 * sl_prev; \
    const bf16x8 qf0 = qlds[0], qf1 = qlds[64], qf2 = qlds[128], qf3 = qlds[192]; \
    VRD(0); SBAR(); float sacc = (P0[0] + P0[1]); \
    GAPA(C0 = __builtin_amdgcn_mfma_f32_32x32x16_bf16(kf[0], qf0, negm, 0, 0, 0), P0[2], P0[3], P0[4], P0[5],     pw0[0] = PKW(P0, 0), pw0[1] = PKW(P0, 2), pw0); \
    VRD(4); SBAR(); GAPA(C1 = __builtin_amdgcn_mfma_f32_32x32x16_bf16(kf[1], qf0, negm, 0, 0, 0), P0[6], P0[7], P0[8], P0[9],     pw0[2] = PKW(P0, 4), pw0[3] = PKW(P0, 6), pw0); \
    VRD(1); SBAR(); GAPA(C0 = __builtin_amdgcn_mfma_f32_32x32x16_bf16(kf[2], qf1, C0, 0, 0, 0),   P0[10], P0[11], P0[12], P0[13], pw1[0] = PKW(P0, 8), pw1[1] = PKW(P0, 10), pw1); \
    VRD(5); SBAR(); GAPA(C1 = __builtin_amdgcn_mfma_f32_32x32x16_bf16(kf[3], qf1, C1, 0, 0, 0),   P0[14], P0[15], P1[0], P1[1],   pw1[2] = PKW(P0, 12), pw1[3] = PKW(P0, 14), pw1); \
    VRD(2); SBAR(); GAPA(C0 = __builtin_amdgcn_mfma_f32_32x32x16_bf16(kf[4], qf2, C0, 0, 0, 0),   P1[2], P1[3], P1[4], P1[5],     pw2[0] = PKW(P1, 0), pw2[1] = PKW(P1, 2), pw2); \
    VRD(6); SBAR(); GAPA(C1 = __builtin_amdgcn_mfma_f32_32x32x16_bf16(kf[5], qf2, C1, 0, 0, 0),   P1[6], P1[7], P1[8], P1[9],     pw2[2] = PKW(P1, 4), pw2[3] = PKW(P1, 6), pw2); \
    VRD(3); SBAR(); GAPA(C0 = __builtin_amdgcn_mfma_f32_32x32x16_bf16(kf[6], qf3, C0, 0, 0, 0),   P1[10], P1[11], P1[12], P1[13], pw3[0] = PKW(P1, 8), pw3[1] = PKW(P1, 10), pw3); \
    VRD(7); SBAR(); GAPA(C1 = __builtin_amdgcn_mfma_f32_32x32x16_bf16(kf[7], qf3, C1, 0, 0, 0),   P1[14], P1[15], 0.f, 0.f,       pw3[2] = PKW(P1, 12), pw3[3] = PKW(P1, 14), pw3); \
    l_reg += sacc; \
    if (GK) { DMA_K((t) + 3, sl_cur); } if (GV) { DMA_V((t) + 1, sl_next); } \
    asm volatile("s_nop 15\n\ts_nop 3" : "+v"(C0), "+v"(C1)); BIAS(C0, C1, t); \
    CMASK(C0, C1, t); \
    { float a = MX3(C0[0], C0[1], C1[0]), b = MX3(C0[2], C0[3], C1[1]); a = MX3(a, C1[2], C1[3]); \
      _Pragma("unroll") for (int r = 4; r < 16; r += 4) { a = MX3(a, C0[r], C0[r + 1]); b = MX3(b, C0[r + 2], C0[r + 3]); a = MX3(a, C1[r], C1[r + 1]); b = MX3(b, C1[r + 2], C1[r + 3]); } \
      float rm = __builtin_fmaxf(a, b); { auto rr = __builtin_amdgcn_permlane32_swap(__float_as_uint(rm), __float_as_uint(rm), false, false); rm = __builtin_fmaxf(__uint_as_float(rr[0]), __uint_as_float(rr[1])); } \
      resc = false; \
      if (__builtin_expect(__any(rm > (float)THRL), 0)) { const float dl = __builtin_fmaxf(rm, 0.f); mhat += dl; \
        _Pragma("unroll") for (int r = 0; r < 16; ++r) { C0[r] -= dl; C1[r] -= dl; } \
        const float f = __builtin_amdgcn_exp2f(-dl); l_reg *= f; if (hi == 0) wsf[r32] = f; resc = true; } } \
    SBAR(); \
    GAPB2(o[0] = __builtin_amdgcn_mfma_f32_32x32x16_bf16(PAF(0), VFR(0), o[0], 0, 0, 0), C0, 0); VRD2(0); \
    GAPB2(o[1] = __builtin_amdgcn_mfma_f32_32x32x16_bf16(PAF(0), VFR(4), o[1], 0, 0, 0), C0, 2); VRD2(4); \
    GAPB2(o[0] = __builtin_amdgcn_mfma_f32_32x32x16_bf16(PAF(1), VFR(1), o[0], 0, 0, 0), C0, 4); VRD2(1); \
    GAPB2(o[1] = __builtin_amdgcn_mfma_f32_32x32x16_bf16(PAF(1), VFR(5), o[1], 0, 0, 0), C0, 6); VRD2(5); \
    GAPB2(o[0] = __builtin_amdgcn_mfma_f32_32x32x16_bf16(PAF(2), VFR(2), o[0], 0, 0, 0), C0, 8); VRD2(2); \
    GAPB2(o[1] = __builtin_amdgcn_mfma_f32_32x32x16_bf16(PAF(2), VFR(6), o[1], 0, 0, 0), C0, 10); VRD2(6); \
    GAPB2(o[0] = __builtin_amdgcn_mfma_f32_32x32x16_bf16(PAF(3), VFR(3), o[0], 0, 0, 0), C0, 12); VRD2(3); \
    GAPB2(o[1] = __builtin_amdgcn_mfma_f32_32x32x16_bf16(PAF(3), VFR(7), o[1], 0, 0, 0), C0, 14); VRD2(7); \
    GAPB2(o[2] = __builtin_amdgcn_mfma_f32_32x32x16_bf16(PAF(0), VFR(0), o[2], 0, 0, 0), C1, 0); \
    GAPB2(o[3] = __builtin_amdgcn_mfma_f32_32x32x16_bf16(PAF(0), VFR(4), o[3], 0, 0, 0), C1, 2); \
    KRD(GL, 0); GAPB2(o[2] = __builtin_amdgcn_mfma_f32_32x32x16_bf16(PAF(1), VFR(1), o[2], 0, 0, 0), C1, 4); \
    KRD(GL, 1); GAPB2(o[3] = __builtin_amdgcn_mfma_f32_32x32x16_bf16(PAF(1), VFR(5), o[3], 0, 0, 0), C1, 6); \
    KRD(GL, 2); GAPB2(o[2] = __builtin_amdgcn_mfma_f32_32x32x16_bf16(PAF(2), VFR(2), o[2], 0, 0, 0), C1, 8); \
    KRD(GL, 3); GAPB2(o[3] = __builtin_amdgcn_mfma_f32_32x32x16_bf16(PAF(2), VFR(6), o[3], 0, 0, 0), C1, 10); \
    GAPB2(o[2] = __builtin_amdgcn_mfma_f32_32x32x16_bf16(PAF(3), VFR(3), o[2], 0, 0, 0), C1, 12); \
    GAPB2(o[3] = __builtin_amdgcn_mfma_f32_32x32x16_bf16(PAF(3), VFR(7), o[3], 0, 0, 0), C1, 14); \
    } while (0)
  int t = 1;
  #undef CMASK
  #define CMASK(P0, P1, t) do {} while (0)
  for (; t + 5 < NT; t += 2) {
    STEP(pB0, pB1, pA0, pA1, t, true, true, true);     WAIT_BAR(3); RESC(); ROT();
    STEP(pA0, pA1, pB0, pB1, t + 1, true, true, true); WAIT_BAR(3); RESC(); ROT();
  }
  #undef CMASK
  #define CMASK(P0, P1, t) do { int jb_ = (t) - (NT - 4); if (jb_ >= 0) cmask(P0, P1, jb_, qrel, hi); } while (0)
  #define ENDW(tt) do { if ((tt) + 3 < NT) { WAIT_BAR(3); } else if ((tt) + 2 < NT) { WAIT_BAR(2); } else { WAIT_BAR(0); } } while (0)
  for (; t + 1 < NT; t += 2) {
    STEP(pB0, pB1, pA0, pA1, t, (t + 3 < NT), (t + 1 < NT), (t + 1 < NT));     ENDW(t);     RESC(); ROT();
    STEP(pA0, pA1, pB0, pB1, t + 1, (t + 4 < NT), (t + 2 < NT), (t + 2 < NT)); ENDW(t + 1); RESC(); ROT();
  }
  STEP(pB0, pB1, pA0, pA1, NT - 1, false, false, false); RESC();
  { float sacc = pB0[0] + pB0[1]; _Pragma("unroll") for (int r = 2; r < 16; ++r) sacc += pB0[r]; _Pragma("unroll") for (int r = 0; r < 16; ++r) sacc += pB1[r]; l_reg += sacc;
    pw0 = (u32x4){PKW(pB0, 0), PKW(pB0, 2), PKW(pB0, 4), PKW(pB0, 6)}; pw1 = (u32x4){PKW(pB0, 8), PKW(pB0, 10), PKW(pB0, 12), PKW(pB0, 14)}; pw2 = (u32x4){PKW(pB1, 0), PKW(pB1, 2), PKW(pB1, 4), PKW(pB1, 6)}; pw3 = (u32x4){PKW(pB1, 8), PKW(pB1, 10), PKW(pB1, 12), PKW(pB1, 14)};
    SBAR(); pv(o, vb0 + 2 * sl_cur, PAF(0), PAF(1), PAF(2), PAF(3)); pv(o + 2, vb0 + 2 * sl_cur + 8192, PAF(0), PAF(1), PAF(2), PAF(3)); }
  #undef PKW
  #undef PAF
  #undef VFR
  #undef PIN
  #undef MX3
  #undef GAPA
  #undef GAPB
  #undef EX
  #undef VRD
  #undef VRD2
  #undef GAPB2
  #undef KRD
  #undef STEP
  #undef ENDW
  { auto rr = __builtin_amdgcn_permlane32_swap(__float_as_uint(l_reg), __float_as_uint(l_reg), false, false); l_reg = __uint_as_float(rr[0]) + __uint_as_float(rr[1]); }
  if (hi == 0) wsf[32 + r32] = l_reg; asm volatile("s_waitcnt lgkmcnt(0)" ::: "memory");
  float rli[16];
  #pragma unroll
  for (int r = 0; r < 16; ++r) rli[r] = __builtin_amdgcn_rcpf(wsf[32 + crow(r, hi)]);
  bf16* Ow = O + (rowbase + q0 + wid * QBLK) * op + oc;
  asm volatile("s_waitcnt lgkmcnt(0)\n\ts_barrier" ::: "memory");
  { bf16* stg = (bf16*)shm + wid * 4096;
    #pragma unroll
    for (int r = 0; r < 16; ++r) { const int orow = crow(r, hi);
      #pragma unroll
      for (int d0 = 0; d0 < 4; ++d0) stg[orow * 128 + d0 * 32 + r32] = __float2bfloat16(o[d0][r] * rli[r]); }
    asm volatile("s_waitcnt lgkmcnt(0)" ::: "memory");
    #pragma unroll
    for (int i = 0; i < 8; ++i) { const int row = i * 4 + (lane >> 4), ch = lane & 15; const u32x4 v = *(const u32x4*)(stg + row * 128 + ch * 8); ATTN_STORE16(Ow + (long)row * op + ch * 8, v); } }
  asm volatile("s_waitcnt lgkmcnt(0)\n\ts_barrier" ::: "memory");
  #undef DMA_K
  #undef DMA_V
  #undef CMASK
  #undef BIAS
  #undef START
  #undef RESC
  #undef ROT
}
#undef SBAR
#undef WAIT_BAR
}

#define XB_TMO      128
#define XB_XCNT(j)  (256  + 64 * (j))
#define XB_XSUB(j)  (1280 + 64 * (j))
#define XB_XGEN(j)  (2304 + 64 * (j))
#define XB_TOP      3328
#define XB_TOPGEN   3392
#define XCD_BAR_WORDS 3456
#define XB_SPIN_CAP (1u << 18)
__device__ __forceinline__ unsigned xb_ld(unsigned* p)              { return __hip_atomic_load(p, __ATOMIC_RELAXED, __HIP_MEMORY_SCOPE_AGENT); }
__device__ __forceinline__ unsigned xb_add(unsigned* p, unsigned v) { return __hip_atomic_fetch_add(p, v, __ATOMIC_RELAXED, __HIP_MEMORY_SCOPE_AGENT); }
__device__ __forceinline__ unsigned xb_xcc_id() { return (unsigned)__builtin_amdgcn_s_getreg((3 << 11) | 20) & 0xFu; }
#define XB_SPIN(cond, bar) do { unsigned _sp = 0; while (cond) { __builtin_amdgcn_s_sleep(1); \
    if ((++_sp & 255u) == 0u) { if (xb_ld(&(bar)[XB_TMO])) break; if (_sp > XB_SPIN_CAP) { atomicAdd(&(bar)[XB_TMO], 1u); break; } } } } while (0)
struct XcdBarrier { unsigned* bar; unsigned x; volatile LAS unsigned* st; };
__device__ __forceinline__ XcdBarrier xcd_barrier_post(unsigned* bar, volatile LAS unsigned* st, const bool t0) {
    XcdBarrier b; b.bar = bar; b.x = xb_xcc_id(); b.st = st;
    if (t0) (void)xb_add(&bar[XB_XCNT(b.x)], 1u);
    return b;
}
__device__ __forceinline__ void xcd_barrier_complete(unsigned* bar, unsigned x, unsigned& nloc, unsigned& nx) {
    const unsigned G = gridDim.x * gridDim.y * gridDim.z;
    unsigned sum, cnt, mine, sp = 0u;
    for (;;) {
        sum = 0u; cnt = 0u; mine = 0u;
#pragma unroll
        for (unsigned j = 0; j < 16; ++j) { const unsigned c = xb_ld(&bar[XB_XCNT(j)]); sum += c; cnt += (c > 0u) ? 1u : 0u; mine = (j == x) ? c : mine; }
        if (sum == G) break;
        __builtin_amdgcn_s_sleep(1);
        if ((++sp & 255u) == 0u) { if (xb_ld(&bar[XB_TMO])) break; if (sp > XB_SPIN_CAP) { atomicAdd(&bar[XB_TMO], 1u); break; } }
    }
    nloc = mine > 0u ? mine : 1u; nx = cnt > 0u ? cnt : 1u;
}
template <int JOB> __device__ __forceinline__ void barrier_job(const struct Ctx& c);
template <int JOB> __device__ __forceinline__ void xcd_barrier(const XcdBarrier& b, const bool t0, const struct Ctx& c) {
    asm volatile("s_waitcnt vmcnt(0)" ::: "memory");
    __syncthreads();
    if (t0) {
        unsigned* bar = b.bar;
        __builtin_amdgcn_s_waitcnt(0);
        unsigned nloc = b.st[0], nx = b.st[1];
        if (nloc == 0u) { xcd_barrier_complete(bar, b.x, nloc, nx); b.st[0] = nloc; b.st[1] = nx; }
        const unsigned old = xb_add(&bar[XB_XSUB(b.x)], 1u);
        const unsigned gen = old / nloc;
        if (old + 1u == (gen + 1u) * nloc) {
            __builtin_amdgcn_fence(__ATOMIC_RELEASE, "agent");
            asm volatile("s_waitcnt vmcnt(0)" ::: "memory");
            const unsigned og = xb_add(&bar[XB_TOP], 1u);
            const unsigned tg = og / nx;
            if (og + 1u == (tg + 1u) * nx) xb_add(&bar[XB_TOPGEN], 1u);
            else XB_SPIN(xb_ld(&bar[XB_TOPGEN]) == tg, bar);
            __builtin_amdgcn_fence(__ATOMIC_ACQUIRE, "agent");
            asm volatile("s_waitcnt vmcnt(0)" ::: "memory");
        } else {
            XB_SPIN(xb_ld(&bar[XB_TOPGEN]) == gen, bar);
            __builtin_amdgcn_fence(__ATOMIC_ACQUIRE, "agent");
            asm volatile("s_waitcnt vmcnt(0)" ::: "memory");
        }
    }
    if constexpr (JOB != 0) barrier_job<JOB>(c);
    __syncthreads();
}

#define LG_FLAG(g) (8192 + 64 * (g))
#define LG_CNT(g)  (8704 + 64 * (g))
#define LG_GEN(g)  (9216 + 64 * (g))
template <int JOB> __device__ __forceinline__ void group_barrier(const XcdBarrier& b, unsigned* ctl, const int g, const bool t0, const struct Ctx& c) {
    asm volatile("s_waitcnt vmcnt(0)" ::: "memory");
    __syncthreads();
    if (t0) {
        unsigned* bar = b.bar;
        __builtin_amdgcn_s_waitcnt(0);
        const unsigned old = xb_add(&ctl[LG_CNT(g)], 1u);
        const unsigned gen = old >> 5;
        if (old + 1u == (gen + 1u) << 5) xb_add(&ctl[LG_GEN(g)], 1u);
        else XB_SPIN(xb_ld(&ctl[LG_GEN(g)]) == gen, bar);
        __builtin_amdgcn_fence(__ATOMIC_ACQUIRE, "agent");
        asm volatile("s_waitcnt vmcnt(0)" ::: "memory");
    }
    if constexpr (JOB != 0) barrier_job<JOB>(c);
    __syncthreads();
}

__device__ __forceinline__ void cvt_item(const float* W, int K, int N, bf16* WT, bool qkperm, const float* nw, LAS float* scr, int item, int lane) {
    const int nblk = N / 32, kb = item / nblk, nb = item % nblk, k0 = 64 * kb, n0 = 32 * nb;
    float wv_[32];
#pragma unroll
    for (int i = 0; i < 32; ++i) { const int kk = 2 * i + (lane >> 5); wv_[i] = W[(size_t)(k0 + kk) * N + n0 + (lane & 31)]; }
#pragma unroll
    for (int i = 0; i < 32; ++i) { const int kk = 2 * i + (lane >> 5); scr[kk * 33 + (lane & 31)] = wv_[i]; }
    LDS_WAIT(); asm volatile("" ::: "memory");
    int rb = n0; if (qkperm && n0 < 2048) { const int c = n0 & 255; rb = (n0 & ~255) + ((c >> 5) & 1) * 128 + (c >> 6) * 32; }
    const int c = lane & 7;
    f32x4 w0 = (f32x4){1.f, 1.f, 1.f, 1.f}, w1 = w0; if (nw) { w0 = *(const GAS f32x4*)(nw + k0 + 8 * c); w1 = *(const GAS f32x4*)(nw + k0 + 8 * c + 4); }
#pragma unroll
    for (int j = 0; j < 4; ++j) { const int n = (lane >> 3) + 8 * j; const LAS float* s = scr + (8 * c) * 33 + n;
        v4u o; o.x = pk2(s[0 * 33] * w0[0], s[1 * 33] * w0[1]); o.y = pk2(s[2 * 33] * w0[2], s[3 * 33] * w0[3]); o.z = pk2(s[4 * 33] * w1[0], s[5 * 33] * w1[1]); o.w = pk2(s[6 * 33] * w1[2], s[7 * 33] * w1[3]);
        *(GAS v4u*)(WT + (size_t)(rb + n) * K + k0 + 8 * c) = o; }
    LDS_WAIT(); asm volatile("" ::: "memory");
}
__device__ __forceinline__ void cvt_pair(const float* W0, int K0, int N0, bf16* T0, bool perm0, const float* nw0, const float* W1, int K1, int N1, bf16* T1, LAS unsigned char* lds, int gw, int ngw, int wave, int lane) {
    LAS float* scr = (LAS float*)(lds + wave * 16384);
    const int i0 = (K0 / 64) * (N0 / 32), i1 = (K1 / 64) * (N1 / 32);
    for (int it = gw; it < i0 + i1; it += ngw) { if (it < i0) cvt_item(W0, K0, N0, T0, perm0, nw0, scr, it, lane); else cvt_item(W1, K1, N1, T1, false, nullptr, scr, it - i0, lane); }
}
__device__ __forceinline__ void prep_rows(const float* x, bf16* XB, float* SQ, int gw, int ngw, int lane) {
    for (int m0 = gw; m0 < M; m0 += 4 * ngw) {
        f32x4 v[4][4];
#pragma unroll
        for (int q = 0; q < 4; ++q) { const int m = m0 + q * ngw; if (m < M) { const GAS f32x4* xr = (const GAS f32x4*)(x + (size_t)m * D) + lane;
#pragma unroll
            for (int j = 0; j < 4; ++j) v[q][j] = xr[64 * j]; } }
#pragma unroll
        for (int q = 0; q < 4; ++q) { const int m = m0 + q * ngw; if (m < M) { float s = 0.f;
#pragma unroll
            for (int j = 0; j < 4; ++j) s += (v[q][j].x * v[q][j].x + v[q][j].y * v[q][j].y) + (v[q][j].z * v[q][j].z + v[q][j].w * v[q][j].w);
            const float ssum = wave_sum(s);
            GAS v2u* o8 = (GAS v2u*)(XB + (size_t)m * D) + lane;
#pragma unroll
            for (int j = 0; j < 4; ++j) { v2u o; o.x = pk2(v[q][j].x, v[q][j].y); o.y = pk2(v[q][j].z, v[q][j].w); o8[64 * j] = o; }
            if (lane == 0) *((GAS f32x4*)SQ + m) = (f32x4){ssum, 0.f, 0.f, 0.f}; } }
    }
}
struct Args { const float* in[18]; float* out; unsigned char* ws; int ph_lo, ph_hi; };
struct Ctx { LAS unsigned char* L; gu32* ctl; int wave, G, bx, vcu, gw, ngw, lo, hi; XcdBarrier bar; };
typedef __attribute__((address_space(4))) const unsigned char* kptr_t;
__device__ __forceinline__ kptr_t kargs() { kptr_t p = (kptr_t)__builtin_amdgcn_kernarg_segment_ptr(); asm volatile("" : "+s"(p)); return p; }
template <class T> __device__ __forceinline__ T kld(kptr_t p, int off) { return *(const __attribute__((address_space(4))) T*)(p + off); }
#define KP_IN(k) kld<const float*>(kp, 8 * (k))
#define PHB if (PH_ON) { const int lane = lane_now(), tid = c.wave * 64 + lane; (void)tid; const kptr_t kp = kargs(); unsigned char* const ws = kld<unsigned char*>(kp, 152); float* const xo = kld<float*>(kp, 144); (void)xo; (void)ws;
#define P_H ((bf16*)(ws + WS_H))
#define P_WIN ((bf16*)(ws + WS_WIN))
#define P_WOUT ((bf16*)(ws + WS_WOUT))
#define P_WUP ((bf16*)(ws + WS_WUP))
#define P_WDN ((bf16*)(ws + WS_WDN))
#define P_QT ((bf16*)(ws + WS_QT))
#define P_KTK ((bf16*)(ws + WS_KTK))
#define P_KF ((bf16*)(ws + WS_KF))
#define P_VT ((bf16*)(ws + WS_VT))
#define P_G ((bf16*)(ws + WS_G))
#define P_P ((bf16*)(ws + WS_P))
#define P_ST ((bf16*)xo)
#define P_SS ((float*)(ws + WS_SS))
#define P_AQ ((bf16*)(ws + WS_AQ))
#define P_AK ((bf16*)(ws + WS_AK))
#define P_AV ((bf16*)(ws + WS_AV))
#define P_OB ((bf16*)(ws + WS_OB))
#define P_OB1 ((bf16*)(ws + WS_OB1))
#define P_Y ((bf16*)(ws + WS_Y))
#define P_KM ((bf16*)(ws + WS_KM))
#define P_U ((bf16*)(ws + WS_U))
#define P_RN ((float*)(ws + WS_RN))
#define P_SQ ((float*)(ws + WS_SQ))
#define PH_ON (ph >= c.lo && ph < c.hi)
enum { J_NONE = 0, J_UP = 1  , J_DN = 5  , J_MIX1 = 9, J_MIX2 = 10, J_MIXIN3 = 11, J_MIXOUT3 = 12, J_UPDN = 13   };
constexpr size_t DS_W1IN = 0, DS_W1OUT = 6 * MiB, DS_W2IN = 8 * MiB, DS_W2OUT = 14 * MiB, DS_W3IN = 16 * MiB;
template <int JOB, bool LOCAL = false> __device__ __forceinline__ void ph_end(const Ctx& c, int& ph) {
    if (PH_ON && ph + 1 < c.hi) { const bool t0 = (c.wave == 0) && (lane_now() == 0);
        if (MK_PER_PHASE) { if (t0) __hip_atomic_store(c.ctl + CW_TMO, 0xBADBA0u, RLX_AGENT); }
        else { bool grp = false; if constexpr (LOCAL) grp = __builtin_amdgcn_readfirstlane((int)((volatile LAS unsigned*)(c.L + MISC_OFF))[12]) != 0;
            if (grp) group_barrier<JOB>(c.bar, (unsigned*)c.ctl, c.bx & 7, t0, c); else xcd_barrier<JOB>(c.bar, t0, c); } }
    ++ph;
}
#define PH_END ph_end<J_NONE>(c, ph)
#define PH_END_J(J) ph_end<(J)>(c, ph)
#define PH_END_LOCAL_J(J) ph_end<(J), true>(c, ph)
template <int JOB> __device__ __forceinline__ void barrier_job(const Ctx& c) {
    if (c.wave == 0) return;
    const int lane = lane_now(); const kptr_t kp = kargs(); unsigned char* const ws = kld<unsigned char*>(kp, 152); unsigned char* const dsc = (unsigned char*)kld<float*>(kp, 144);
    const int gw7 = c.vcu * (NWAVES - 1) + (c.wave - 1), ngw7 = c.G * (NWAVES - 1);
    if constexpr (JOB >= J_UP && JOB < J_UP + 4) { constexpr int LY = JOB - J_UP;
        cvt_pair(KP_IN(4) + (size_t)LY * D * FF, D, FF, P_WUP, false, KP_IN(3) + LY * D, nullptr, 0, 0, nullptr, c.L, gw7, ngw7, c.wave, lane); }
    else if constexpr (JOB >= J_DN && JOB < J_DN + 4) { constexpr int LY = JOB - J_DN;
        cvt_pair(KP_IN(5) + (size_t)LY * FF * D, FF, D, P_WDN, false, nullptr, nullptr, 0, 0, nullptr, c.L, gw7, ngw7, c.wave, lane); }
    else if constexpr (JOB >= J_UPDN && JOB < J_UPDN + 4) { constexpr int LY = JOB - J_UPDN;
        cvt_pair(KP_IN(4) + (size_t)LY * D * FF, D, FF, P_WUP, false, KP_IN(3) + LY * D, KP_IN(5) + (size_t)LY * FF * D, FF, D, P_WDN, c.L, gw7, ngw7, c.wave, lane); }
    else if constexpr (JOB == J_MIX1) cvt_pair(KP_IN(8), D, 3 * D, (bf16*)(dsc + DS_W1IN), true, KP_IN(2) + 1 * D, KP_IN(11), D, D, (bf16*)(dsc + DS_W1OUT), c.L, gw7, ngw7, c.wave, lane);
    else if constexpr (JOB == J_MIX2) cvt_pair(KP_IN(12), D, 3 * D, (bf16*)(dsc + DS_W2IN), true, KP_IN(2) + 2 * D, KP_IN(17), D, D, (bf16*)(dsc + DS_W2OUT), c.L, gw7, ngw7, c.wave, lane);
    else if constexpr (JOB == J_MIXIN3) cvt_pair(KP_IN(6) + (size_t)1 * D * RIN, D, RIN, (bf16*)(dsc + DS_W3IN), false, KP_IN(2) + 3 * D, nullptr, 0, 0, nullptr, c.L, gw7, ngw7, c.wave, lane);
    else if constexpr (JOB == J_MIXOUT3) cvt_pair(KP_IN(7) + (size_t)1 * RH * RDV * D, RH * RDV, D, P_WOUT, false, nullptr, nullptr, 0, 0, nullptr, c.L, gw7, ngw7, c.wave, lane);
}

template <int KIND> __device__ __forceinline__ void cvt_mixer(const kptr_t kp, unsigned char* const ws, const Ctx& c, const int lane, int j, const float* nw, bf16* const win_dst) {
    if constexpr (KIND == 0) cvt_pair(KP_IN(6) + (size_t)j * D * RIN, D, RIN, win_dst, false, nw, KP_IN(7) + (size_t)j * RH * RDV * D, RH * RDV, D, P_WOUT, c.L, c.gw, c.ngw, c.wave, lane);
    else if constexpr (KIND == 1) cvt_pair(KP_IN(8), D, 3 * D, P_WIN, true, nw, KP_IN(11), D, D, P_WOUT, c.L, c.gw, c.ngw, c.wave, lane);
    else cvt_pair(KP_IN(12), D, 3 * D, P_WIN, true, nw, KP_IN(17), D, D, P_WOUT, c.L, c.gw, c.ngw, c.wave, lane);
}
#define CVT_MLP() cvt_pair(KP_IN(4) + (size_t)LAYER * D * FF, D, FF, P_WUP, false, KP_IN(3) + LAYER * D, KP_IN(5) + (size_t)LAYER * FF * D, FF, D, P_WDN, c.L, c.gw, c.ngw, c.wave, lane)

#define PRELOAD_SQ(NMAX, ROW, FUNC) { pg8::Unit u_; LAS float* tb_ = (LAS float*)(L + 139264); f32x4 a_[NMAX]; bool v_[NMAX]; \
    _Pragma("unroll") for (int i_ = 0; i_ < NMAX; ++i_) { v_[i_] = S.next(i_, u_); a_[i_] = (f32x4){1.f, 1.f, 1.f, 1.f}; if (v_[i_] && tid < 256) a_[i_] = *((const GAS f32x4*)P_SQ + ((ROW) * 256 + tid)); } \
    _Pragma("unroll") for (int i_ = 0; i_ < NMAX; ++i_) if (v_[i_] && tid < 256) tb_[i_ * 256 + tid] = FUNC(((a_[i_].x + a_[i_].y) + (a_[i_].z + a_[i_].w)) * (1.f / D) + EPS); \
    __syncthreads(); }
template <int LAYER> __device__ __forceinline__ void ret_rest(const Ctx& c, int& ph) {
    PHB
        for (int item = c.bx * (NWAVES * 64) + tid; item < 16 * 16384; item += c.G * NWAVES * 64) {
            const int bhl = item >> 14, v = item & 16383, h = bhl & 3;
            const float g256 = __builtin_amdgcn_exp2f(256.f * __builtin_amdgcn_logf(1.0f - __builtin_amdgcn_exp2f(-5.0f - (float)h)));
            GAS v4u* p = (GAS v4u*)(P_ST + (size_t)bhl * 16 * 131072) + v;
            v4u t[16];
#pragma unroll
            for (int n = 0; n < 16; ++n) t[n] = p[(size_t)n * 16384];
            float s[8] = {0.f, 0.f, 0.f, 0.f, 0.f, 0.f, 0.f, 0.f};
#pragma unroll
            for (int n = 0; n < 16; ++n) {
                v4u o; o.x = pk2(s[0], s[1]); o.y = pk2(s[2], s[3]); o.z = pk2(s[4], s[5]); o.w = pk2(s[6], s[7]);
                p[(size_t)n * 16384] = o;
                s[0] = g256 * (s[0] + bflo(t[n].x)); s[1] = g256 * (s[1] + bfhi(t[n].x)); s[2] = g256 * (s[2] + bflo(t[n].y)); s[3] = g256 * (s[3] + bfhi(t[n].y));
                s[4] = g256 * (s[4] + bflo(t[n].z)); s[5] = g256 * (s[5] + bfhi(t[n].z)); s[6] = g256 * (s[6] + bflo(t[n].w)); s[7] = g256 * (s[7] + bfhi(t[n].w));
            }
        }
    }
    PH_END_J(J_DN + LAYER);
    PHB
        pg8::SchedRetO S{(const char*)P_P, (const char*)P_QT, (const char*)P_VT, (const char*)P_ST, c.G, c.vcu};
        pg8::EpiRetOut E{P_G, P_SS};
        pg8::gemm_phase<pg8::EpiRetOut, pg8::SchedRetO, true, true>(c.L + RING_OFF, c.wave, pg8::GemmP{256, 256, 4, 4}, S, E);
    }
    PH_END;
}

template <int LAYER> __device__ __forceinline__ void do_layer(const Ctx& c, int& ph) {
    extern __shared__ __attribute__((aligned(16))) unsigned char lds[];
    constexpr int KIND = LAYER % 3, J = LAYER / 3;
    const int G = c.G, bx = c.bx, gw = c.gw, ngw = c.ngw;
    LAS unsigned char* const L = c.L;
    if constexpr (KIND == 0) {
        PHB
            pg8::SchedRetIn S{(const char*)P_H, (LAYER == 3) ? (const char*)xo + DS_W3IN : (const char*)P_WIN, G, bx};
            PRELOAD_SQ(6, (u_.ty >= 3 ? u_.pn : u_.pm), __builtin_amdgcn_rsqf)
            pg8::EpiRetIn E{P_QT, P_KTK, P_KF, P_VT, P_G, (const LAS float*)(L + 139264), L + 147456};
            pg8::gemm_phase<pg8::EpiRetIn, pg8::SchedRetIn, true, true>(L + RING_OFF, c.wave, pg8::GemmP{1024, 1024, 16, 0}, S, E);
        }
        PH_END;
        PHB
            pg8::SchedRetPS S{(const char*)P_QT, (const char*)P_KTK, (const char*)P_VT, (const char*)P_KF, G, c.vcu};
            pg8::EpiMaskState E{pg8::EpiMask{P_P}, pg8::EpiState{P_ST}};
            pg8::gemm_phase<pg8::EpiMaskState, pg8::SchedRetPS, true, true>(L + RING_OFF, c.wave, pg8::GemmP{256, 256, 4, 0}, S, E);
        }
        PH_END_J(J_UP + LAYER);
        ret_rest<LAYER>(c, ph);
        PHB
            pg8::SchedPlain S{(const char*)P_G, (const char*)P_WOUT, 64, 4, G, bx, (size_t)256 * 2048 * 2, (size_t)256 * 2048 * 2};
            { pg8::Unit u_; LAS float* tb_ = (LAS float*)(L + 139264);
              if (S.next(0, u_) && tid < 256) { float r_[4];
#pragma unroll
                  for (int h_ = 0; h_ < 4; ++h_) { const GAS f32x4* sp_ = (const GAS f32x4*)(P_SS + (size_t)((u_.pm * 256 + tid) * 4 + h_) * 8); const f32x4 s0_ = sp_[0], s1_ = sp_[1];
                      r_[h_] = __builtin_amdgcn_rsqf(((s0_.x + s0_.y) + (s0_.z + s0_.w) + (s1_.x + s1_.y) + (s1_.z + s1_.w)) * (1.f / 512.f) + EPS); }
                  tb_[tid] = r_[0] / r_[1]; tb_[256 + tid] = r_[1] / r_[2]; tb_[512 + tid] = r_[2] / r_[3]; tb_[768 + tid] = r_[3]; }
              __syncthreads(); }
            pg8::EpiResH E{P_H, xo, P_SQ, (LAS float*)(L + 135168), (const LAS float*)(L + 139264)};
            pg8::gemm_phase<pg8::EpiResH, pg8::SchedPlain, true, true>(L + RING_OFF, c.wave, pg8::GemmP{2048, 2048, 32, 0}, S, E);
        }
        PH_END_LOCAL_J(LAYER == 0 ? J_MIX1 : J_NONE);
    } else {
        PHB
            pg8::SchedPlain S{(const char*)P_H, (const char*)xo + (KIND == 1 ? DS_W1IN : DS_W2IN), 64, 12, G, bx, (size_t)256 * 1024 * 2, (size_t)256 * 1024 * 2};
            PRELOAD_SQ(3, u_.pm, __builtin_amdgcn_rsqf)
            if (KIND == 1) ((LAS float*)(L + 135168))[tid] = 0.f;
            pg8::EpiQKNorm<KIND == 1> E{P_AQ, P_AK, P_AV, (KIND == 1) ? KP_IN(9) : KP_IN(13), (KIND == 1) ? KP_IN(10) : KP_IN(14), (const LAS float*)(L + 139264), (KIND == 1) ? (pg8::bf16_t*)P_KM : nullptr, (LAS float*)(L + 135168)};
            pg8::gemm_phase<pg8::EpiQKNorm<KIND == 1>, pg8::SchedPlain, true, true>(L + RING_OFF, c.wave, pg8::GemmP{1024, 1024, 16, 0}, S, E);
        }
        PH_END_J(J_UPDN + LAYER);
        const int abh = c.vcu >> 2, as_ = c.vcu & 3, ab = abh >> 4, ah = abh & 15;
        if constexpr (KIND == 1) {
        PHB
            if (G == 256) {
                const float* const rel_bias = KP_IN(1);
                LAS float* tab = (LAS float*)(L + attn_body::LDS_TAB);
                for (int xx = tid; xx < attn_body::TAB_N; xx += NWAVES * 64) { const int d = xx - 256; float v = 0.f;
                    if (d >= 0) { int bk = d; if (d >= 16) { bk = 16 + (d >= 21) + (d >= 27) + (d >= 35) + (d >= 46) + (d >= 59) + (d >= 77) + (d >= 99) + (d >= 128) + (d >= 166) + (d >= 216) + (d >= 280) + (d >= 363) + (d >= 470) + (d >= 609) + (d >= 790); }
                        v = (rel_bias[bk * 16 + ah] - rel_bias[31 * 16 + ah]) * LOG2E; }
                    tab[xx] = v; }
                __syncthreads();
                for (int i = 0; i < 4; ++i) { const int qb = (i == 0) ? as_ : (i == 1) ? 7 - as_ : (i == 2) ? 8 + as_ : 15 - as_;
                    attn_body::attn_unit<1, 8, 1024>(ab, qb, (const attn_body::bf16*)P_AQ, ah * 64, (const attn_body::bf16*)P_AK, ah * 64, (const attn_body::bf16*)P_AV, ah * 64,
                                               (attn_body::bf16*)P_OB1, ah * 64, (const attn_body::bf16*)P_KM + (size_t)ab * 64 * 1024 + ah * 64, (char*)lds, c.wave);
                }
            }
        }
        PH_END_J(J_MIX2);
        } else {
        PHB
            if (G == 256) {
                const int pr_ = c.vcu >> 3, as8 = c.vcu & 7, ab2 = pr_ >> 3, hd2 = pr_ & 7;
                const float* const rel_bias = KP_IN(1);
                LAS float* tab = (LAS float*)(L + attn_body::V2_TAB);
                for (int hh = 0; hh < 2; ++hh) { const int ah = 2 * hd2 + hh;
                    __syncthreads();
                for (int xx = tid; xx < attn_body::TAB_N; xx += NWAVES * 64) { const int d = xx - 256; float v = 0.f;
                    if (d >= 0) { int bk = d; if (d >= 16) { bk = 16 + (d >= 21) + (d >= 27) + (d >= 35) + (d >= 46) + (d >= 59) + (d >= 77) + (d >= 99) + (d >= 128) + (d >= 166) + (d >= 216) + (d >= 280) + (d >= 363) + (d >= 470) + (d >= 609) + (d >= 790); }
                        v = (rel_bias[bk * 16 + ah] - rel_bias[31 * 16 + ah]) * LOG2E; }
                    tab[xx] = v; }
                    __syncthreads();
                    for (int i = 0; i < 2; ++i) { const int qb = i ? 15 - as8 : as8;
                        attn_body::attn_unit_v128<8>(ab2, qb, (const attn_body::bf16*)P_AQ, ah * 64, (const attn_body::bf16*)P_AK, ah * 64, (const attn_body::bf16*)P_AV, hd2 * 128,
                                                     (attn_body::bf16*)P_OB, ah * 128, (char*)lds, c.wave);
                    }
                }
                asm volatile("s_waitcnt vmcnt(0)" ::: "memory"); __syncthreads();
                __builtin_amdgcn_fence(__ATOMIC_ACQUIRE, "agent"); asm volatile("s_waitcnt vmcnt(0)" ::: "memory");
                const int ln_ = lane_now();
                const float* lam = KP_IN(15); const float* subln = KP_IN(16);
                const float linit = 0.8f - 0.6f * 0.5488116360940264f;
                const float s01 = wave_sum(lam[ln_] * lam[64 + ln_]), s23 = wave_sum(lam[128 + ln_] * lam[192 + ln_]);
                const float lfull = __builtin_amdgcn_exp2f(s01 * LOG2E) - __builtin_amdgcn_exp2f(s23 * LOG2E) + linit;
                const int seg = ln_ & 7;
                f32x4 sw[4];
#pragma unroll
                for (int j = 0; j < 4; ++j) sw[j] = *((const GAS f32x4*)(subln + seg * 16) + j);
                for (int hf = 0; hf < 2; ++hf) { const int qb = hf ? 15 - as8 : as8; const size_t m0 = (size_t)ab2 * SEQ + qb * 256 + c.wave * 8 + (ln_ >> 3);
                    v4u u1[4][2], u2[4][2];
#pragma unroll
                    for (int q = 0; q < 4; ++q) { const size_t m = m0 + q * 64;
                        const GAS v4u* p1 = (const GAS v4u*)(P_OB + m * 2048 + (2 * hd2) * 128 + seg * 16);
                        const GAS v4u* p2 = (const GAS v4u*)(P_OB + m * 2048 + (2 * hd2 + 1) * 128 + seg * 16);
#pragma unroll
                        for (int j = 0; j < 2; ++j) { u1[q][j] = p1[j]; u2[q][j] = p2[j]; } }
#pragma unroll
                    for (int q = 0; q < 4; ++q) { const size_t m = m0 + q * 64;
                        float a[16]; float ss = 0.f;
#pragma unroll
                        for (int j = 0; j < 2; ++j) { const v4u w1 = u1[q][j], w2 = u2[q][j];
                            a[8 * j + 0] = bflo(w1.x) - lfull * bflo(w2.x); a[8 * j + 1] = bfhi(w1.x) - lfull * bfhi(w2.x); a[8 * j + 2] = bflo(w1.y) - lfull * bflo(w2.y); a[8 * j + 3] = bfhi(w1.y) - lfull * bfhi(w2.y);
                            a[8 * j + 4] = bflo(w1.z) - lfull * bflo(w2.z); a[8 * j + 5] = bfhi(w1.z) - lfull * bfhi(w2.z); a[8 * j + 6] = bflo(w1.w) - lfull * bflo(w2.w); a[8 * j + 7] = bfhi(w1.w) - lfull * bfhi(w2.w); }
#pragma unroll
                        for (int j = 0; j < 16; ++j) ss += a[j] * a[j];
                        ss += __shfl_xor(ss, 1); ss += __shfl_xor(ss, 2); ss += __shfl_xor(ss, 4);
                        const float r = __builtin_amdgcn_rsqf(ss * (1.f / 128.f) + EPS) * (1.0f - linit);
                        GAS v4u* po = (GAS v4u*)(P_Y + m * 1024 + hd2 * 128 + seg * 16);
#pragma unroll
                        for (int j = 0; j < 2; ++j) { v4u o;
                            o.x = pk2(a[8 * j + 0] * r * sw[2 * j][0], a[8 * j + 1] * r * sw[2 * j][1]); o.y = pk2(a[8 * j + 2] * r * sw[2 * j][2], a[8 * j + 3] * r * sw[2 * j][3]);
                            o.z = pk2(a[8 * j + 4] * r * sw[2 * j + 1][0], a[8 * j + 5] * r * sw[2 * j + 1][1]); o.w = pk2(a[8 * j + 6] * r * sw[2 * j + 1][2], a[8 * j + 7] * r * sw[2 * j + 1][3]); po[j] = o; }
                    }
                }
            }
        }
        PH_END_J(J_MIXIN3);
        }
        PHB
            pg8::SchedPlain S{(const char*)((KIND == 1) ? P_OB1 : P_Y), (const char*)xo + (KIND == 1 ? DS_W1OUT : DS_W2OUT), 64, 4, G, bx, (size_t)256 * 1024 * 2, (size_t)256 * 1024 * 2};
            pg8::EpiRes<false> E{P_H, xo, P_SQ, (LAS float*)(L + 135168)};
            pg8::gemm_phase<pg8::EpiRes<false>, pg8::SchedPlain, true, true>(L + RING_OFF, c.wave, pg8::GemmP{1024, 1024, 16, 0}, S, E);
        }
        PH_END_LOCAL_J(J_NONE);
    }
    PHB
        pg8::SchedPlain S{(const char*)P_H, (const char*)P_WUP, 64, 16, G, bx, (size_t)256 * 1024 * 2, (size_t)256 * 1024 * 2};
        PRELOAD_SQ(4, u_.pm, __builtin_amdgcn_rcpf)
        pg8::EpiUp E{P_U, (const LAS float*)(L + 139264)};
        pg8::gemm_phase<pg8::EpiUp, pg8::SchedPlain, true, true>(L + RING_OFF, c.wave, pg8::GemmP{1024, 1024, 16, 0}, S, E);
    }
    PH_END_LOCAL_J(LAYER == 2 ? J_MIXOUT3 : J_NONE);
    PHB
        pg8::SchedPlain S{(const char*)P_U, (const char*)P_WDN, 64, 4, G, bx, (size_t)256 * 4096 * 2, (size_t)256 * 4096 * 2};
        pg8::EpiRes<(LAYER == 3)> E{P_H, xo, P_SQ, (LAS float*)(L + 135168)};
        pg8::gemm_phase<pg8::EpiRes<(LAYER == 3)>, pg8::SchedPlain, true, true>(L + RING_OFF, c.wave, pg8::GemmP{4096, 4096, 64, 0}, S, E);
    }
    PH_END;
}

__global__ void __launch_bounds__(NWAVES * 64, 2) trunk_fwd(Args args) {
    extern __shared__ __attribute__((aligned(16))) unsigned char lds[];
    Ctx c;
    c.L = (LAS unsigned char*)lds;
    volatile LAS unsigned* const MISC = (volatile LAS unsigned*)(c.L + MISC_OFF);
    const int tid0 = threadIdx.x; c.wave = __builtin_amdgcn_readfirstlane(tid0 >> 6);
    c.G = gridDim.x; c.bx = blockIdx.x;
    c.vcu = (c.G % 8 == 0) ? (c.bx % 8) * (c.G / 8) + c.bx / 8 : c.bx;
    c.gw = c.vcu * NWAVES + c.wave; c.ngw = c.G * NWAVES;
    c.ctl = (gu32*)(args.ws + WS_CTL);
    for (int u = tid0; u < (LDS_BYTES - LDSCTL_OFF) / 4; u += NWAVES * 64) ((LAS unsigned*)(c.L + LDSCTL_OFF))[u] = 0u;
    __syncthreads();
    c.bar.bar = (unsigned*)(c.ctl + CW_BAR); c.bar.x = 0; c.bar.st = nullptr;
    if (!MK_PER_PHASE) c.bar = xcd_barrier_post((unsigned*)(c.ctl + CW_BAR), MISC + 8, tid0 == 0);
    if (!MK_PER_PHASE && tid0 == 0) (void)__hip_atomic_fetch_or(c.ctl + LG_FLAG(c.bx & 7), 1u << c.bar.x, RLX_AGENT);
    c.lo = args.ph_lo; c.hi = args.ph_hi;
    int ph = 0;
    PHB cvt_mixer<0>(kp, ws, c, lane, 0, KP_IN(2), P_WIN); prep_rows(KP_IN(0), P_H, P_SQ, c.gw, c.ngw, lane);
        for (int i = c.bx * (NWAVES * 64) + tid; i < 4 * 48 * 128; i += c.G * NWAVES * 64) { const int b = i / (48 * 128), r = (i / 128) % 48, cc = i % 128;
            *((GAS v4u*)(P_KM + ((size_t)(b * 64 + 16 + r)) * 1024) + cc) = (v4u){0u, 0u, 0u, 0u}; } }
    PH_END;
    if (!MK_PER_PHASE) {
        if (tid0 == 0) { unsigned ok = (c.G == 256) ? 1u : 0u;
            for (int g = 0; g < 8; ++g) { const unsigned f = xb_ld((unsigned*)c.ctl + LG_FLAG(g)); ok &= (f != 0u && (f & (f - 1u)) == 0u) ? 1u : 0u; }
            MISC[12] = ok; }
        __syncthreads(); }
    do_layer<0>(c, ph);
    do_layer<1>(c, ph);
    do_layer<2>(c, ph);
    do_layer<3>(c, ph);
}
#undef PH_ON
#undef PH_END


constexpr int N_PHASES = 1 + (5 + 2) + (3 + 2) + (3 + 2) + (5 + 2);
extern "C" void kernel_launch(void* const* d_in, const int* in_sizes, int n_in, void* d_out, int out_size, void* d_ws, size_t ws_size, hipStream_t stream) {
    static int grid = 0;
    if (grid == 0) {
        if (n_in != 18 || in_sizes[0] != M * D || out_size != M * D || ws_size < WS_END) { fprintf(stderr, "kernel_launch: unexpected shapes (n_in %d, in0 %d, out %d, ws %zu < %zu); nothing launched\n", n_in, n_in > 0 ? in_sizes[0] : -1, out_size, ws_size, (size_t)WS_END); grid = -1; return; }
        int dev = 0, cus = 0, per_cu = 0;
        if (hipGetDevice(&dev) != hipSuccess || hipDeviceGetAttribute(&cus, hipDeviceAttributeMultiprocessorCount, dev) != hipSuccess) { grid = -1; return; }
        if (hipFuncSetAttribute((const void*)trunk_fwd, hipFuncAttributeMaxDynamicSharedMemorySize, LDS_BYTES) != hipSuccess) { fprintf(stderr, "kernel_launch: hipFuncSetAttribute failed\n"); grid = -1; return; }
        if (hipOccupancyMaxActiveBlocksPerMultiprocessor(&per_cu, (const void*)trunk_fwd, NWAVES * 64, LDS_BYTES) != hipSuccess || per_cu < 1)
            fprintf(stderr, "kernel_launch: note: occupancy query reports %d workgroups per CU\n", per_cu);
        (void)hipGetLastError();
        grid = cus;
        if (grid != 256) fprintf(stderr, "kernel_launch: %d CUs; the attention phases need a 256-workgroup grid\n", grid);
    }
    if (grid < 0) return;
    if (hipMemsetAsync((char*)d_ws + WS_CTL, 0, CTL_ZERO_BYTES, stream) != hipSuccess) return;
    Args a{};
    for (int i = 0; i < 18; ++i) a.in[i] = (const float*)d_in[i];
    a.out = (float*)d_out; a.ws = (unsigned char*)d_ws;
#if MK_PER_PHASE
    for (int p = 0; p < N_PHASES; ++p) { a.ph_lo = p; a.ph_hi = p + 1; hipLaunchKernelGGL(trunk_fwd, dim3(grid), dim3(NWAVES * 64), LDS_BYTES, stream, a); }
#else
    a.ph_lo = 0; a.ph_hi = N_PHASES;
    hipLaunchKernelGGL(trunk_fwd, dim3(grid), dim3(NWAVES * 64), LDS_BYTES, stream, a);
#endif
    const hipError_t le = hipPeekAtLastError();
    if (le != hipSuccess) fprintf(stderr, "kernel_launch: launch failed: %s\n", hipGetErrorName(le));
}
```
